# Optimizing an MI355X kernel written in HIP

```python
import math
import jax, jax.numpy as jnp
from jax import lax
import numpy as np

D_MODEL = 2048
BATCH = 4
SEQ = 2048
DEPTH = 4

HEAD_DIM = 128
N_MEM_HEADS = 4
MEM_WIDTH = N_MEM_HEADS * HEAD_DIM
SELF_WIDTH = D_MODEL - MEM_WIDTH
N_SELF_HEADS = SELF_WIDTH // HEAD_DIM
DIFF_HALF = HEAD_DIM // 2
N_MEM = 256
MOBA_BLOCK = 256
MOBA_TOPK = 3
MOBA_Q_CHUNK = 16
DENSE_Q_BLOCK = 128
N_BUCKETS = 32
MAX_DISTANCE = 128
D_FF = -(-8 * D_MODEL // (3 * 256)) * 256
N_A = DEPTH // 2
N_B = DEPTH - N_A
RMS_EPS = 1e-6
NEG = -1e30

kernel_name = "yoco_moba_diffattn_hybrid"


def rmsnorm(x, g):
    xf = x.astype(jnp.float32)
    y = xf * lax.rsqrt(jnp.mean(xf * xf, axis=-1, keepdims=True) + RMS_EPS)
    return (y * g.astype(jnp.float32)).astype(x.dtype)


def rel_bucket(rel):
    n = jnp.maximum(rel, 0)
    max_exact = N_BUCKETS // 2
    nf = jnp.maximum(n, 1).astype(jnp.float32)
    large = max_exact + (jnp.log(nf / max_exact) / math.log(MAX_DISTANCE / max_exact)
                         * (N_BUCKETS - max_exact)).astype(jnp.int32)
    large = jnp.minimum(large, N_BUCKETS - 1)
    return jnp.where(n < max_exact, n, large)


def split_heads(t, n):
    B, S, _ = t.shape
    return t.reshape(B, S, n, -1).transpose(0, 2, 1, 3)


def merge_heads(t):
    B, n, S, Dh = t.shape
    return t.transpose(0, 2, 1, 3).reshape(B, S, n * Dh)


def moba_attention(q, k, v, rel_bias):
    B, H, S, Dh = q.shape
    nb = -(-S // MOBA_BLOCK)
    S_pad = nb * MOBA_BLOCK
    pad = [(0, 0), (0, 0), (0, S_pad - S), (0, 0)]
    q, k, v = jnp.pad(q, pad), jnp.pad(k, pad), jnp.pad(v, pad)
    kb = k.reshape(B, H, nb, MOBA_BLOCK, Dh)
    vb = v.reshape(B, H, nb, MOBA_BLOCK, Dh)
    k_mean = jnp.mean(kb.astype(jnp.float32), axis=3)
    gate = jnp.einsum('bhsd,bhnd->bhsn', q.astype(jnp.float32), k_mean)
    q_blk = jnp.arange(S_pad, dtype=jnp.int32) // MOBA_BLOCK
    past = jnp.arange(nb, dtype=jnp.int32)[None, :] < q_blk[:, None]
    gate = jnp.where(past, gate, NEG)
    n_sel = max(1, min(MOBA_TOPK, nb - 1))
    _, sel = lax.top_k(gate, n_sel)
    own = jnp.broadcast_to(q_blk[None, None, :, None], (B, H, S_pad, 1)).astype(sel.dtype)
    blocks = jnp.concatenate([sel, own], axis=-1)
    nk = n_sel + 1
    n_chunk = S_pad // MOBA_Q_CHUNK

    def to_chunks(t):
        t = t.reshape(B, H, n_chunk, MOBA_Q_CHUNK, *t.shape[3:])
        return jnp.moveaxis(t, 2, 0)

    pos = jnp.arange(S_pad, dtype=jnp.int32).reshape(n_chunk, MOBA_Q_CHUNK)
    bi = jnp.arange(B)[:, None, None, None]
    hi = jnp.arange(H)[None, :, None, None]
    bias_t = rel_bias.T.astype(jnp.float32)
    own_slot = (jnp.arange(nk) == nk - 1)[:, None]
    scale = Dh ** -0.5
    offs = jnp.arange(MOBA_BLOCK, dtype=jnp.int32)

    def chunk(args):
        qc, blk, qpos = args
        ks = kb[bi, hi, blk]
        vs = vb[bi, hi, blk]
        kpos = blk[..., None].astype(jnp.int32) * MOBA_BLOCK + offs
        s = jnp.einsum('bhcd,bhcnld->bhcnl', qc, ks).astype(jnp.float32) * scale
        rel = qpos[:, None, None] - kpos
        s = s + bias_t[hi[..., None], rel_bucket(rel)]
        qb = qpos // MOBA_BLOCK
        past_ok = (blk < qb[:, None])[..., None]
        causal_ok = kpos <= qpos[:, None, None]
        valid = jnp.where(own_slot, causal_ok, past_ok)
        s = jnp.where(valid, s, NEG)
        Cq = qc.shape[2]
        p = jax.nn.softmax(s.reshape(B, H, Cq, nk * MOBA_BLOCK), axis=-1)
        p = p.reshape(B, H, Cq, nk, MOBA_BLOCK).astype(vs.dtype)
        return jnp.einsum('bhcnl,bhcnld->bhcd', p, vs)

    out = lax.map(chunk, (to_chunks(q), to_chunks(blocks), pos))
    out = jnp.moveaxis(out, 0, 2).reshape(B, H, S_pad, Dh)
    return out[:, :, :S]


def diff_attention(q1, q2, k1, k2, v, lam, rel_bias):
    B, H, S, d = q1.shape
    nqb = S // DENSE_Q_BLOCK
    kpos = jnp.arange(S, dtype=jnp.int32)
    scale = d ** -0.5
    table = rel_bias.astype(jnp.float32)

    def to_chunks(t):
        t = t.reshape(B, H, nqb, DENSE_Q_BLOCK, t.shape[-1])
        return jnp.moveaxis(t, 2, 0)

    qpos_all = jnp.arange(S, dtype=jnp.int32).reshape(nqb, DENSE_Q_BLOCK)

    def blk(args):
        q1c, q2c, qpos = args
        rel = qpos[:, None] - kpos[None, :]
        bias = jnp.moveaxis(table[rel_bucket(rel)], -1, 0)
        causal = rel >= 0

        def probs(qc, kc):
            s = jnp.einsum('bhqd,bhkd->bhqk', qc, kc).astype(jnp.float32) * scale + bias
            return jax.nn.softmax(jnp.where(causal, s, NEG), axis=-1)

        a = probs(q1c, k1) - lam * probs(q2c, k2)
        return jnp.einsum('bhqk,bhkd->bhqd', a.astype(v.dtype), v)

    out = lax.map(blk, (to_chunks(q1), to_chunks(q2), qpos_all))
    return jnp.moveaxis(out, 0, 2).reshape(B, H, S, v.shape[-1])


def mem_attention(q, mk, mv):
    s = jnp.einsum('bhsd,bhmd->bhsm', q, mk).astype(jnp.float32) * (q.shape[-1] ** -0.5)
    p = jax.nn.softmax(s, axis=-1).astype(mv.dtype)
    return jnp.einsum('bhsm,bhmd->bhsd', p, mv)


def setup_inputs(seed: int = 0) -> dict:
    key = jax.random.key(seed)
    ks = jax.random.split(key, 20)
    f32 = jnp.float32

    def w(k, shape, fan_in):
        return jax.random.normal(k, shape, f32) * (fan_in ** -0.5)

    def gain(k, shape):
        return 1.0 + 0.02 * jax.random.normal(k, shape, f32)

    return {
        "x": jax.random.normal(ks[0], (BATCH, SEQ, D_MODEL), f32),
        "mem": jax.random.normal(ks[1], (BATCH, N_MEM, D_MODEL), f32),
        "rel_bias": 0.5 * jax.random.normal(ks[2], (N_BUCKETS, N_SELF_HEADS), f32),
        "g_mix": gain(ks[3], (DEPTH, D_MODEL)),
        "w_in_a": w(ks[4], (N_A, D_MODEL, 3 * SELF_WIDTH + MEM_WIDTH), D_MODEL),
        "w_in_b": w(ks[5], (N_B, D_MODEL, SELF_WIDTH + MEM_WIDTH), D_MODEL),
        "g_mem": gain(ks[6], (DEPTH, D_MODEL)),
        "w_mem_kv": w(ks[7], (DEPTH, D_MODEL, 2 * MEM_WIDTH), D_MODEL),
        "w_o": w(ks[8], (DEPTH, D_MODEL, D_MODEL), D_MODEL),
        "g_ffn": gain(ks[9], (DEPTH, D_MODEL)),
        "w_gate_up": w(ks[10], (DEPTH, D_MODEL, 2 * D_FF), D_MODEL),
        "w_down": w(ks[11], (DEPTH, D_FF, D_MODEL), D_FF),
        "g_kv": gain(ks[12], (D_MODEL,)),
        "w_kv_shared": w(ks[13], (D_MODEL, 2 * SELF_WIDTH), D_MODEL),
        "lambda_qk": 0.1 * jax.random.normal(ks[14], (N_B, 4, DIFF_HALF), f32),
        "g_subln": gain(ks[15], (N_B, HEAD_DIM)),
        "g_final": gain(ks[16], (D_MODEL,)),
    }


def reference(x, mem, rel_bias, g_mix, w_in_a, w_in_b, g_mem, w_mem_kv, w_o, g_ffn,
              w_gate_up, w_down, g_kv, w_kv_shared, lambda_qk, g_subln, g_final):
    h = x
    k1 = k2 = v_sh = None
    for l in range(DEPTH):
        xn = rmsnorm(h, g_mix[l])
        mkv = rmsnorm(mem, g_mem[l]) @ w_mem_kv[l]
        mk = split_heads(mkv[..., :MEM_WIDTH], N_MEM_HEADS)
        mv = split_heads(mkv[..., MEM_WIDTH:], N_MEM_HEADS)
        if l < N_A:
            proj = xn @ w_in_a[l]
            q = split_heads(proj[..., :SELF_WIDTH], N_SELF_HEADS)
            k = split_heads(proj[..., SELF_WIDTH:2 * SELF_WIDTH], N_SELF_HEADS)
            v = split_heads(proj[..., 2 * SELF_WIDTH:3 * SELF_WIDTH], N_SELF_HEADS)
            qm = proj[..., 3 * SELF_WIDTH:]
            y_self = moba_attention(q, k, v, rel_bias)
        else:
            if l == N_A:
                kv = rmsnorm(h, g_kv) @ w_kv_shared
                kh = split_heads(kv[..., :SELF_WIDTH], N_SELF_HEADS)
                k1, k2 = kh[..., :DIFF_HALF], kh[..., DIFF_HALF:]
                v_sh = split_heads(kv[..., SELF_WIDTH:], N_SELF_HEADS)
            j = l - N_A
            proj = xn @ w_in_b[j]
            qh = split_heads(proj[..., :SELF_WIDTH], N_SELF_HEADS)
            q1, q2 = qh[..., :DIFF_HALF], qh[..., DIFF_HALF:]
            qm = proj[..., SELF_WIDTH:]
            lam_init = 0.8 - 0.6 * math.exp(-0.3 * l)
            lq = lambda_qk[j].astype(jnp.float32)
            lam = jnp.exp(jnp.sum(lq[0] * lq[1])) - jnp.exp(jnp.sum(lq[2] * lq[3])) + lam_init
            o = diff_attention(q1, q2, k1, k2, v_sh, lam, rel_bias)
            y_self = (rmsnorm(o, g_subln[j]) * (1.0 - lam_init)).astype(o.dtype)
        y_mem = mem_attention(split_heads(qm, N_MEM_HEADS), mk, mv)
        y = jnp.concatenate([merge_heads(y_self), merge_heads(y_mem)], axis=-1) @ w_o[l]
        h = h + y
        gu = rmsnorm(h, g_ffn[l]) @ w_gate_up[l]
        h = h + (jax.nn.silu(gu[..., :D_FF]) * gu[..., D_FF:]) @ w_down[l]
    return rmsnorm(h, g_final)
```

```cpp
#include <hip/hip_runtime.h>
#include <hip/hip_cooperative_groups.h>
#include <cstdio>
#include <cstdint>
#include <cmath>
namespace cg = cooperative_groups;
#ifndef MK_N_LAUNCHES
#define MK_N_LAUNCHES 1
#endif
namespace pg8 {
#define PG8_LAS __attribute__((address_space(3)))
typedef unsigned short bf16_t;
typedef short bf16x8 __attribute__((ext_vector_type(8)));
typedef float f32x4 __attribute__((ext_vector_type(4)));
typedef unsigned u32x4 __attribute__((ext_vector_type(4)));
constexpr int BM = 256, BK = 64, HALF = 128, HTB = HALF * BK * 2  , STAGE_BYTES = 8 * HTB, NXCD = 8, WGM = 8;

__host__ __device__ __forceinline__ int lds_byte(int r, int c) { const int st = (r >> 4) * 2 + (c >> 5), rr = r & 15, cc = c & 31, ob = rr * 64 + cc * 2; return st * 1024 + (ob ^ (((ob >> 9) & 1) << 5)); }
__host__ __device__ __forceinline__ void stage_rc(int b, int& R, int& C) { const int st = b / 1024, sb = b % 1024, swz = sb ^ (((sb >> 9) & 1) << 5); R = (st >> 1) * 16 + swz / 64; C = (st & 1) * 32 + (swz % 64) / 2; }
__host__ __device__ __forceinline__ int perm32(int rho) { const int n = rho >> 4, i = rho & 15; return 8 * (i >> 2) + 4 * n + (i & 3); }

struct Unit { int pm, pn, par, sub; };
struct Gemm { const bf16_t* A; const bf16_t* Bt; int M, N, K; };

struct StaticOrder {
    int nM, nN, nwg, G, c, allow_half;
    __host__ __device__ void init(int M, int N, int G_, int c_) { nM = M / BM; nN = N / BM; nwg = nM * nN; G = G_; c = c_; allow_half = 0; }
    __host__ __device__ bool next(int i, Unit& u) const {
        u.sub = -1; long L = (long)i * G + c;
        { const int full = nwg / G, rem = nwg - full * G;
          if (allow_half && rem * 2 == G && i == full) { L = (long)i * G + (c >> 1); u.sub = c & 1; } }
        if (L >= nwg) return false;
        int wgid = (int)L; { const int q = nwg / NXCD, r = nwg % NXCD, xcd = wgid % NXCD, off = wgid / NXCD; wgid = (xcd < r ? xcd * (q + 1) : r * (q + 1) + (xcd - r) * q) + off; }
        const int nig = WGM * nN, gid = wgid / nig, fm = gid * WGM, gsz = (nM - fm) < WGM ? (nM - fm) : WGM;
        u.pm = fm + ((wgid % nig) % gsz); u.pn = (wgid % nig) / gsz; return true;
    }
    __device__ __forceinline__ void a_ready(const Unit&) const {}
    __device__ __forceinline__ void done(const Unit&) const {}
};

__device__ __forceinline__ unsigned cvt_pk_bf16(float lo, float hi) { unsigned r; asm volatile("v_cvt_pk_bf16_f32 %0, %1, %2" : "=v"(r) : "v"(lo), "v"(hi)); return r; }
typedef float f32x2 __attribute__((ext_vector_type(2)));
__device__ __forceinline__ f32x2 gelu_pk(f32x2 v) {
    const f32x2 av = __builtin_elementwise_abs(v), d = av * 0.2316418882f + 1.0f;
    f32x2 t; t.x = __builtin_amdgcn_rcpf(d.x); t.y = __builtin_amdgcn_rcpf(d.y);
    f32x2 q = t * 0.5307027145f + (-0.7265760135f); q = q * t + 0.7107068705f; q = q * t + (-0.142248368f); q = q * t + 0.127414796f; q = q * t;
    const f32x2 s = (v * v) * (-0.72134752044f);
    f32x2 e; e.x = __builtin_amdgcn_exp2f(s.x); e.y = __builtin_amdgcn_exp2f(s.y);
    const f32x2 m = v * (q * e), r = v - m;
    f32x2 o; o.x = v.x < 0.f ? m.x : r.x; o.y = v.y < 0.f ? m.y : r.y; return o;
}

template <int ACT  > struct EpiBf16 {
    static constexpr bool PERM = true, AFTER_DRAIN = false; static_assert(ACT == 0 || ACT == 1, "EpiBf16: ACT is 0 (none) or 1 (gelu_pk)");
    bf16_t* O; int ldc; const float* bias; int split_cols; size_t split_stride; float scale0;
    __device__ __forceinline__ void operator()(const f32x4 (&acc)[2][2][4][2], const Unit& u, int wr, int wc, int fr, int fq) const {
        const int row0 = u.pm * BM + wr * 64 + fr; int colt = u.pn * BM; bf16_t* base = O;
        float sc = 1.f; if (split_cols) { const int t = colt / split_cols; base += (size_t)t * split_stride; colt -= t * split_cols; if (t == 0) sc = scale0; }
        const int col0 = colt + wc * 32 + 8 * fq, bcol0 = u.pn * BM + wc * 32 + 8 * fq;
        f32x4 bv[2][2];
#pragma unroll
        for (int bj = 0; bj < 2; ++bj)
#pragma unroll
            for (int n = 0; n < 2; ++n) bv[bj][n] = bias ? *(const f32x4*)(bias + bcol0 + bj * HALF + 4 * n) : (f32x4){0.f, 0.f, 0.f, 0.f};
#pragma unroll
        for (int ai = 0; ai < 2; ++ai)
#pragma unroll
            for (int m = 0; m < 4; ++m) { bf16_t* rowp = base + (size_t)(row0 + ai * HALF + m * 16) * ldc + col0;
#pragma unroll
                for (int bj = 0; bj < 2; ++bj) { f32x4 v0 = acc[ai][bj][m][0] + bv[bj][0], v1 = acc[ai][bj][m][1] + bv[bj][1];
                    if (ACT == 1) { f32x2 a = gelu_pk((f32x2){v0[0], v0[1]}), b = gelu_pk((f32x2){v0[2], v0[3]}), c = gelu_pk((f32x2){v1[0], v1[1]}), d = gelu_pk((f32x2){v1[2], v1[3]});
                        v0 = (f32x4){a.x, a.y, b.x, b.y}; v1 = (f32x4){c.x, c.y, d.x, d.y}; }
                    v0 = v0 * sc; v1 = v1 * sc; u32x4 w; w.x = cvt_pk_bf16(v0[0], v0[1]); w.y = cvt_pk_bf16(v0[2], v0[3]); w.z = cvt_pk_bf16(v1[0], v1[1]); w.w = cvt_pk_bf16(v1[2], v1[3]);
                    *(u32x4*)(rowp + bj * HALF) = w; } }
    }
};
template <class Epi, class Sched, bool ALIGN_EPI = false, bool SP2 = false>
__device__ __forceinline__ void gemm_phase(PG8_LAS unsigned char* lds, const Gemm g, const Sched& S, const Epi& E) {
    int tid_ = threadIdx.x; asm volatile("" : "+v"(tid_));
    const int tid = tid_, wid = __builtin_amdgcn_readfirstlane(tid >> 6), lane = tid & 63, wr = wid >> 2, wc = wid & 3, fr = lane & 15, fq = lane >> 4;
    const int K = g.K, nt = K / BK;
    unsigned voffA[2], voffB[2];
#pragma unroll
    for (int i = 0; i < 2; ++i) { int R, C; stage_rc(tid * 16 + i * 8192, R, C); const int Rb = Epi::PERM ? ((R & ~31) + perm32(R & 31)) : R;
        voffA[i] = (unsigned)(R * K + C) * 2u; voffB[i] = (unsigned)(Rb * K + C) * 2u; }
    const size_t kstep = (size_t)(BK * 2);
    const size_t hstep = (size_t)HALF * K * 2;
    const size_t tstep = 2 * hstep;
    const unsigned ldsw = (unsigned)wid * 1024u;
    const int aoff = lds_byte(wr * 64 + fr, fq * 8), boff = lds_byte(wc * 32 + fr, fq * 8);
#define PG8_SA(b, h) (((b) * 2 + (h)) * HTB)
#define PG8_SB(b, h) ((4 + (b) * 2 + (h)) * HTB)
#define PG8_STAGE(bufoff, gbase, voff) do { _Pragma("unroll") for (int _i = 0; _i < 2; ++_i) \
        __builtin_amdgcn_global_load_lds((const unsigned*)((const char*)(gbase) + (voff)[_i]), (PG8_LAS unsigned*)(lds + (bufoff) + ldsw + _i * 8192), 16, 0, 0); } while (0)
#define PG8_LDA(dst, b, h) do { _Pragma("unroll") for (int m = 0; m < 4; ++m) _Pragma("unroll") for (int k = 0; k < 2; ++k) dst[m][k] = *(const PG8_LAS bf16x8*)(lds + PG8_SA(b, h) + aoff + m * 2048 + k * 1024); } while (0)
#define PG8_LDB(dst, b, h) do { _Pragma("unroll") for (int n = 0; n < 2; ++n) _Pragma("unroll") for (int k = 0; k < 2; ++k) dst[n][k] = *(const PG8_LAS bf16x8*)(lds + PG8_SB(b, h) + boff + n * 2048 + k * 1024); } while (0)
#define PG8_MMA(ai, bj, At, Bt) do { __builtin_amdgcn_s_setprio(1); _Pragma("unroll") for (int m = 0; m < 4; ++m) _Pragma("unroll") for (int n = 0; n < 2; ++n) _Pragma("unroll") for (int k = 0; k < 2; ++k) \
        acc[ai][bj][m][n] = __builtin_amdgcn_mfma_f32_16x16x32_bf16(Bt[n][k], At[m][k], acc[ai][bj][m][n], 0, 0, 0); __builtin_amdgcn_s_setprio(0); } while (0)
#define PG8_WAIT_V(n) asm volatile("s_waitcnt vmcnt(" #n ")" ::: "memory")
#define PG8_WAIT_L(n) asm volatile("s_waitcnt lgkmcnt(" #n ")" ::: "memory")
#define PG8_BAR __builtin_amdgcn_s_barrier()
#define PG8_SCHED __builtin_amdgcn_sched_barrier(0)
    Unit cur, nxt; int ui = 0;
    if (!S.next(0, cur)) return;
    f32x4 acc[2][2][4][2];
#pragma unroll
    for (int a = 0; a < 2; ++a)
#pragma unroll
        for (int b = 0; b < 2; ++b)
#pragma unroll
            for (int m = 0; m < 4; ++m)
#pragma unroll
                for (int n = 0; n < 2; ++n) acc[a][b][m][n] = (f32x4){0.f, 0.f, 0.f, 0.f};
    bf16x8 At[4][2], B0[2][2], B1[2][2];
    const char* cA = (const char*)g.A + (size_t)cur.pm * tstep + (cur.sub > 0 ? hstep : 0); const char* cB = (const char*)g.Bt + (size_t)cur.pn * tstep;
    bool chalf = cur.sub >= 0; size_t hsc = chalf ? 0 : hstep;
    S.a_ready(cur);
    if constexpr (SP2) {
        PG8_STAGE(PG8_SB(0, 0), cB, voffB); PG8_STAGE(PG8_SB(0, 1), cB + hstep, voffB); PG8_STAGE(PG8_SA(0, 0), cA, voffA); PG8_STAGE(PG8_SA(0, 1), cA + hsc, voffA);
        if (wr == 1) PG8_BAR;
        PG8_WAIT_V(2); PG8_BAR;
        PG8_STAGE(PG8_SB(1, 0), cB + kstep, voffB); PG8_STAGE(PG8_SA(1, 0), cA + kstep, voffA); PG8_STAGE(PG8_SB(1, 1), cB + hstep + kstep, voffB);
        PG8_WAIT_V(6); PG8_BAR;
    } else {
        PG8_STAGE(PG8_SB(0, 0), cB, voffB); PG8_STAGE(PG8_SA(0, 0), cA, voffA); PG8_STAGE(PG8_SB(0, 1), cB + hstep, voffB); PG8_STAGE(PG8_SA(0, 1), cA + hstep, voffA);
        if (wr == 1) PG8_BAR;
        PG8_WAIT_V(4); PG8_BAR;
        PG8_STAGE(PG8_SB(1, 0), cB + kstep, voffB); PG8_STAGE(PG8_SA(1, 0), cA + kstep, voffA); PG8_STAGE(PG8_SB(1, 1), cB + hstep + kstep, voffB);
        PG8_WAIT_V(6); PG8_BAR;
    }
    for (;;) {
        const bool has_next = S.next(ui + 1, nxt);
        const char* nA = has_next ? (const char*)g.A + (size_t)nxt.pm * tstep + (nxt.sub > 0 ? hstep : 0) : cA; const char* nB = has_next ? (const char*)g.Bt + (size_t)nxt.pn * tstep : cB;
        const size_t hsn = has_next ? (nxt.sub >= 0 ? 0 : hstep) : hsc;
        for (int t = 0; t < nt; t += 2) {
            const bool last = (t == nt - 2);
            const char* a1 = cA + (size_t)(t + 1) * kstep;
            const char* a2 = last ? nA : cA + (size_t)(t + 2) * kstep; const char* b2 = last ? nB : cB + (size_t)(t + 2) * kstep;
            const char* a3 = a2 + kstep; const char* b3 = b2 + kstep;
            if (last && has_next) S.a_ready(nxt);
            if constexpr (SP2) {
            PG8_LDB(B0, 0, 0); PG8_LDB(B1, 0, 1); PG8_SCHED; PG8_LDA(At, 0, 0); PG8_STAGE(PG8_SA(1, 1), a1 + hsc, voffA);
            PG8_WAIT_V(8); PG8_WAIT_L(0); PG8_BAR; PG8_MMA(0, 0, At, B0); PG8_MMA(0, 1, At, B1); PG8_BAR; PG8_SCHED;
            if (!chalf) PG8_LDA(At, 0, 1); PG8_STAGE(PG8_SB(0, 0), b2, voffB); PG8_STAGE(PG8_SB(0, 1), b2 + hstep, voffB); PG8_STAGE(PG8_SA(0, 0), a2, voffA);
            PG8_WAIT_V(8); PG8_WAIT_L(0); PG8_BAR; if (!chalf) { PG8_MMA(1, 0, At, B0); PG8_MMA(1, 1, At, B1); } PG8_BAR; PG8_SCHED;
            PG8_LDB(B0, 1, 0); PG8_LDB(B1, 1, 1); PG8_SCHED; PG8_LDA(At, 1, 0); PG8_STAGE(PG8_SA(0, 1), a2 + (last ? hsn : hsc), voffA);
            PG8_WAIT_V(8); PG8_WAIT_L(0); PG8_BAR; PG8_MMA(0, 0, At, B0); PG8_MMA(0, 1, At, B1); PG8_BAR; PG8_SCHED;
            if (!chalf) PG8_LDA(At, 1, 1); PG8_STAGE(PG8_SB(1, 0), b3, voffB); PG8_STAGE(PG8_SB(1, 1), b3 + hstep, voffB); PG8_STAGE(PG8_SA(1, 0), a3, voffA);
            PG8_WAIT_V(8); PG8_WAIT_L(0); PG8_BAR; if (!chalf) { PG8_MMA(1, 0, At, B0); PG8_MMA(1, 1, At, B1); } PG8_BAR; PG8_SCHED;
            } else {
            PG8_LDB(B0, 0, 0); PG8_SCHED; PG8_LDA(At, 0, 0); PG8_STAGE(PG8_SA(1, 1), a1 + hstep, voffA);
            PG8_WAIT_L(8); PG8_BAR; PG8_WAIT_L(0); PG8_MMA(0, 0, At, B0); PG8_BAR; PG8_SCHED;
            PG8_LDB(B1, 0, 1); PG8_STAGE(PG8_SB(0, 0), b2, voffB);
            PG8_BAR; PG8_WAIT_L(0); PG8_MMA(0, 1, At, B1); PG8_BAR;
            PG8_LDA(At, 0, 1); PG8_STAGE(PG8_SA(0, 0), a2, voffA);
            PG8_BAR; PG8_WAIT_L(0); PG8_MMA(1, 0, At, B0); PG8_BAR; PG8_SCHED;
            PG8_STAGE(PG8_SB(0, 1), b2 + hstep, voffB);
            PG8_WAIT_V(6); PG8_BAR; PG8_MMA(1, 1, At, B1); PG8_BAR;
            PG8_LDB(B0, 1, 0); PG8_SCHED; PG8_LDA(At, 1, 0); PG8_STAGE(PG8_SA(0, 1), a2 + hstep, voffA);
            PG8_WAIT_L(8); PG8_BAR; PG8_WAIT_L(0); PG8_MMA(0, 0, At, B0); PG8_BAR; PG8_SCHED;
            PG8_LDB(B1, 1, 1); PG8_STAGE(PG8_SB(1, 0), b3, voffB);
            PG8_BAR; PG8_WAIT_L(0); PG8_MMA(0, 1, At, B1); PG8_BAR;
            PG8_LDA(At, 1, 1); PG8_STAGE(PG8_SA(1, 0), a3, voffA);
            PG8_BAR; PG8_WAIT_L(0); PG8_MMA(1, 0, At, B0); PG8_BAR; PG8_SCHED;
            PG8_STAGE(PG8_SB(1, 1), b3 + hstep, voffB);
            PG8_WAIT_V(6); PG8_BAR; PG8_MMA(1, 1, At, B1); PG8_BAR;
            }
        }
        if constexpr (ALIGN_EPI) { if (wr == 0) PG8_BAR; }
        if constexpr (!Epi::AFTER_DRAIN) { E(acc, cur, wr, wc, fr, fq); S.done(cur); }
        if (!has_next) break;
#pragma unroll
        for (int a = 0; a < 2; ++a)
#pragma unroll
            for (int b = 0; b < 2; ++b)
#pragma unroll
                for (int m = 0; m < 4; ++m)
#pragma unroll
                    for (int n = 0; n < 2; ++n) acc[a][b][m][n] = (f32x4){0.f, 0.f, 0.f, 0.f};
        cur = nxt; cA = nA; cB = nB; ++ui; chalf = cur.sub >= 0; hsc = chalf ? 0 : hstep;
        if constexpr (ALIGN_EPI) { if (wr == 1) PG8_BAR; }
    }
    PG8_WAIT_V(0);
    if constexpr (!ALIGN_EPI) { if (wr == 0) PG8_BAR; }
    PG8_BAR;
    if constexpr (Epi::AFTER_DRAIN) { E.fused(acc, cur, wr, wc, fr, fq, lds, wid, lane); S.done(cur); }
#undef PG8_SA
#undef PG8_SB
#undef PG8_STAGE
#undef PG8_LDA
#undef PG8_LDB
#undef PG8_MMA
#undef PG8_WAIT_V
#undef PG8_WAIT_L
#undef PG8_BAR
#undef PG8_SCHED
}
}

namespace pg8 {
struct RsOrder {
    StaticOrder so; const float* ss; PG8_LAS float* rs;
    static constexpr int MAXU = 8;
    __device__ __forceinline__ bool next(int i, Unit& u) const { const bool ok = so.next(i, u); u.par = i; return ok; }
    __device__ __forceinline__ void build() const {
        if (!ss) return;
        int t_ = threadIdx.x; asm volatile("" : "+v"(t_)); const int t = t_, row = t >> 1, half = t & 1;
#pragma unroll 1
        for (int i0 = 0; i0 < MAXU; i0 += 4) {
            f32x4 acc[4];
#pragma unroll
            for (int i = 0; i < 4; ++i) { Unit u; const bool ok = so.next(i0 + i, u); const int rb = ok ? u.pm * BM + (u.sub > 0 ? HALF : 0) : 0;
                const f32x4* p = (const f32x4*)(ss + (size_t)(rb + row) * 32 + half * 16);
                acc[i] = (p[0] + p[1]) + (p[2] + p[3]); }
#pragma unroll
            for (int i = 0; i < 4; ++i) { float s = (acc[i][0] + acc[i][1]) + (acc[i][2] + acc[i][3]); s += __shfl_xor(s, 1);
                if (!half) rs[(i0 + i) * 256 + row] = rsqrtf(s * (1.0f / 2048.0f) + 1e-6f); }
        }
        __syncthreads();
    }
    __device__ __forceinline__ void a_ready(const Unit&) const {}
    __device__ __forceinline__ void done(const Unit&) const {}
};
struct EpiBf16S {
    static constexpr bool PERM = true, AFTER_DRAIN = false;
    bf16_t* O; int ldc; const PG8_LAS float* rs;
    float* kmp;
    __device__ __forceinline__ void operator()(const f32x4 (&acc)[2][2][4][2], const Unit& u, int wr, int wc, int fr, int fq) const {
        const int row0 = u.pm * BM + (u.sub > 0 ? HALF : 0) + wr * 64 + fr, col0 = u.pn * BM + wc * 32 + 8 * fq;
        const bool dosum = kmp != nullptr && u.pn >= 6 && u.pn < 12;
#pragma unroll
        for (int ai = 0; ai < 2; ++ai) { if (ai == 1 && u.sub >= 0) continue;
            f32x4 cs[2][2] = {{(f32x4){0.f, 0.f, 0.f, 0.f}, (f32x4){0.f, 0.f, 0.f, 0.f}}, {(f32x4){0.f, 0.f, 0.f, 0.f}, (f32x4){0.f, 0.f, 0.f, 0.f}}};
#pragma unroll
            for (int m = 0; m < 4; ++m) { bf16_t* rowp = O + (size_t)(row0 + ai * HALF + m * 16) * ldc + col0;
                const float sc = rs ? rs[u.par * 256 + ai * HALF + wr * 64 + m * 16 + fr] : 1.f;
#pragma unroll
                for (int bj = 0; bj < 2; ++bj) { const f32x4 v0 = acc[ai][bj][m][0] * sc, v1 = acc[ai][bj][m][1] * sc;
                    cs[bj][0] += v0; cs[bj][1] += v1;
                    u32x4 w; w.x = cvt_pk_bf16(v0[0], v0[1]); w.y = cvt_pk_bf16(v0[2], v0[3]); w.z = cvt_pk_bf16(v1[0], v1[1]); w.w = cvt_pk_bf16(v1[2], v1[3]);
                    *(u32x4*)(rowp + bj * HALF) = w; } }
            if (dosum) { const int q = (u.sub >= 0 ? u.sub : ai) * 2 + wr; float* kp = kmp + ((size_t)(u.pm * 4 + q) * 1536) + (u.pn - 6) * BM + wc * 32 + 8 * fq;
#pragma unroll
                for (int bj = 0; bj < 2; ++bj)
#pragma unroll
                    for (int n = 0; n < 2; ++n) { f32x4 t = cs[bj][n];
#pragma unroll
                        for (int x = 1; x < 16; x <<= 1) { t[0] += __shfl_xor(t[0], x); t[1] += __shfl_xor(t[1], x); t[2] += __shfl_xor(t[2], x); t[3] += __shfl_xor(t[3], x); }
                        if (fr == 0) *(f32x4*)(kp + bj * HALF + 4 * n) = t; } } }
    }
};
struct EpiResid {
    static constexpr bool PERM = false, AFTER_DRAIN = false;
    const float* basef; const bf16_t* baseh; bf16_t* out; int ldc; float* ss;
    static __device__ __forceinline__ void sw16(unsigned& a, unsigned& b) { auto r = __builtin_amdgcn_permlane16_swap(a, b, false, false); a = r[0]; b = r[1]; }
    __device__ __forceinline__ float put(bf16_t* dst, const f32x4& va, const f32x4& vb) const {
        unsigned w00 = cvt_pk_bf16(va[0], va[1]), w01 = cvt_pk_bf16(va[2], va[3]), w10 = cvt_pk_bf16(vb[0], vb[1]), w11 = cvt_pk_bf16(vb[2], vb[3]);
        const float r0 = __uint_as_float(w00 << 16), r1 = __uint_as_float(w00 & 0xffff0000u), r2 = __uint_as_float(w01 << 16), r3 = __uint_as_float(w01 & 0xffff0000u);
        const float r4 = __uint_as_float(w10 << 16), r5 = __uint_as_float(w10 & 0xffff0000u), r6 = __uint_as_float(w11 << 16), r7 = __uint_as_float(w11 & 0xffff0000u);
        sw16(w00, w10); sw16(w01, w11);
        *(u32x4*)dst = (u32x4){w00, w01, w10, w11};
        return ((r0 * r0 + r1 * r1) + (r2 * r2 + r3 * r3)) + ((r4 * r4 + r5 * r5) + (r6 * r6 + r7 * r7));
    }
    __device__ __forceinline__ void operator()(const f32x4 (&acc)[2][2][4][2], const Unit& u, int wr, int wc, int fr, int fq) const {
        const int col0 = u.pn * BM + wc * 32 + 4 * fq, wcol = u.pn * BM + wc * 32 + (fq & 1) * 16 + (fq >> 1) * 8;
        if (basef) {
#pragma unroll
            for (int ai = 0; ai < 2; ++ai) {
                f32x4 bs[4][2][2];
#pragma unroll
                for (int m = 0; m < 4; ++m) { const size_t off = (size_t)(u.pm * BM + ai * HALF + wr * 64 + m * 16 + fr) * ldc + col0;
#pragma unroll
                    for (int bj = 0; bj < 2; ++bj)
#pragma unroll
                        for (int n = 0; n < 2; ++n) bs[m][bj][n] = *(const f32x4*)(basef + off + bj * HALF + n * 16); }
#pragma unroll
                for (int m = 0; m < 4; ++m) { const int row = u.pm * BM + ai * HALF + wr * 64 + m * 16 + fr; const size_t off = (size_t)row * ldc + wcol; float s = 0.f;
#pragma unroll
                    for (int bj = 0; bj < 2; ++bj) s += put(out + off + bj * HALF, bs[m][bj][0] + acc[ai][bj][m][0], bs[m][bj][1] + acc[ai][bj][m][1]);
                    s += __shfl_xor(s, 16); s += __shfl_xor(s, 32);
                    if (ss && fq == 0) ss[(size_t)row * 32 + u.pn * 4 + wc] = s; }
                asm volatile("" ::: "memory"); }
        } else {
            u32x4 bh[2][4][2];
#pragma unroll
            for (int ai = 0; ai < 2; ++ai)
#pragma unroll
                for (int m = 0; m < 4; ++m) { const size_t off = (size_t)(u.pm * BM + ai * HALF + wr * 64 + m * 16 + fr) * ldc + wcol;
#pragma unroll
                    for (int bj = 0; bj < 2; ++bj) bh[ai][m][bj] = *(const u32x4*)(baseh + off + bj * HALF); }
#pragma unroll
            for (int ai = 0; ai < 2; ++ai)
#pragma unroll
                for (int m = 0; m < 4; ++m) { const int row = u.pm * BM + ai * HALF + wr * 64 + m * 16 + fr; const size_t off = (size_t)row * ldc + wcol; float s = 0.f;
#pragma unroll
                    for (int bj = 0; bj < 2; ++bj) { unsigned ax = bh[ai][m][bj][0], ay = bh[ai][m][bj][1], bx = bh[ai][m][bj][2], by = bh[ai][m][bj][3]; sw16(ax, bx); sw16(ay, by);
                        const f32x4 ba = (f32x4){__uint_as_float(ax << 16), __uint_as_float(ax & 0xffff0000u), __uint_as_float(ay << 16), __uint_as_float(ay & 0xffff0000u)};
                        const f32x4 bb = (f32x4){__uint_as_float(bx << 16), __uint_as_float(bx & 0xffff0000u), __uint_as_float(by << 16), __uint_as_float(by & 0xffff0000u)};
                        s += put(out + off + bj * HALF, ba + acc[ai][bj][m][0], bb + acc[ai][bj][m][1]); }
                    s += __shfl_xor(s, 16); s += __shfl_xor(s, 32);
                    if (ss && fq == 0) ss[(size_t)row * 32 + u.pn * 4 + wc] = s; }
        }
    }
};
struct EpiSwiGLU {
    static constexpr bool PERM = true, AFTER_DRAIN = false;
    bf16_t* O; int ldc; const PG8_LAS float* rs;
    static __device__ __forceinline__ float sw(float g, float u) { return g * __builtin_amdgcn_rcpf(1.0f + __builtin_amdgcn_exp2f(-1.4426950408889634f * g)) * u; }
    __device__ __forceinline__ void operator()(const f32x4 (&acc)[2][2][4][2], const Unit& u, int wr, int wc, int fr, int fq) const {
        const int row0 = u.pm * BM + (u.sub > 0 ? HALF : 0) + wr * 64 + fr, col0 = u.pn * HALF + wc * 32 + 8 * fq;
        float scv[2][4];
#pragma unroll
        for (int ai = 0; ai < 2; ++ai)
#pragma unroll
            for (int m = 0; m < 4; ++m) scv[ai][m] = rs[u.par * 256 + ai * HALF + wr * 64 + m * 16 + fr];
#pragma unroll
        for (int ai = 0; ai < 2; ++ai)
#pragma unroll
            for (int m = 0; m < 4; ++m) { if (ai == 1 && u.sub >= 0) continue; bf16_t* rowp = O + (size_t)(row0 + ai * HALF + m * 16) * ldc + col0;
                const float sc = scv[ai][m];
                const f32x4 g0 = acc[ai][0][m][0] * sc, g1 = acc[ai][0][m][1] * sc, u0 = acc[ai][1][m][0] * sc, u1 = acc[ai][1][m][1] * sc;
                u32x4 w; w.x = cvt_pk_bf16(sw(g0[0], u0[0]), sw(g0[1], u0[1])); w.y = cvt_pk_bf16(sw(g0[2], u0[2]), sw(g0[3], u0[3]));
                w.z = cvt_pk_bf16(sw(g1[0], u1[0]), sw(g1[1], u1[1])); w.w = cvt_pk_bf16(sw(g1[2], u1[2]), sw(g1[3], u1[3]));
                *(u32x4*)rowp = w; asm volatile("" ::: "memory"); }
    }
};
}

namespace att {
typedef unsigned short bf16_t;
using bf16x8 = __attribute__((ext_vector_type(8))) short;
using s16x4  = __attribute__((ext_vector_type(4))) short;
using f32x16 = __attribute__((ext_vector_type(16))) float;
using f32x4  = __attribute__((ext_vector_type(4))) float;
using u32x4  = __attribute__((ext_vector_type(4))) unsigned;
constexpr int NW = 8, QBLK = 32, KVBLK = 64;
constexpr int SHM_V = 16384, SHM_K = 16384;
#ifndef PIPE_OFF_MODE
#define PIPE_OFF_MODE 1
#endif
constexpr int NSLOT = 4, SLOTB = 32768;
constexpr int OFF_WS = NSLOT * SLOTB, OFF_LUT = OFF_WS + 2048, OFF_KM = OFF_LUT + 2560, OFF_MISC = OFF_KM + 3584, ATT_LDS = OFF_MISC + 64;
constexpr float L2E = 1.4426950408889634f;
constexpr float THRL = 8.f;
#define KSWZ(row, colB) ((row) * 256 + ((colB) ^ (((row) & 7) << 4)))
#define SBAR() __builtin_amdgcn_sched_barrier(0)
__device__ __forceinline__ int crow(int r, int hi) { return (r & 3) + 8 * (r >> 2) + 4 * hi; }
__device__ __forceinline__ unsigned cvtpk(float lo, float hi) { unsigned r; asm volatile("v_cvt_pk_bf16_f32 %0, %1, %2" : "=v"(r) : "v"(lo), "v"(hi)); return r; }
__device__ __forceinline__ unsigned short f2bf(float f) { unsigned u = __builtin_bit_cast(unsigned, f); return (unsigned short)((u + 0x7fffu + ((u >> 16) & 1u)) >> 16); }
__device__ __forceinline__ int bucket(int d) {
  return d < 16 ? d : 16 + (d >= 19) + (d >= 21) + (d >= 24) + (d >= 27) + (d >= 31) + (d >= 35) + (d >= 40) + (d >= 46) + (d >= 52) + (d >= 59) + (d >= 67) + (d >= 77) + (d >= 87) + (d >= 99) + (d >= 113);
}
__device__ __forceinline__ void partialSM(f32x16& p0, f32x16& p1, float& m_reg, float& alpha) {
  float pmax = p0[0];
#pragma unroll
  for (int r = 1; r < 16; ++r) pmax = fmaxf(pmax, p0[r]);
#pragma unroll
  for (int r = 0; r < 16; ++r) pmax = fmaxf(pmax, p1[r]);
  { auto rr = __builtin_amdgcn_permlane32_swap(__float_as_uint(pmax), __float_as_uint(pmax), false, false);
    pmax = fmaxf(__uint_as_float(rr[0]), __uint_as_float(rr[1])); }
  float mn;
  if (__builtin_expect(__all(pmax - m_reg <= THRL), 1)) { mn = m_reg; alpha = 1.f; }
  else { mn = fmaxf(m_reg, pmax); alpha = __builtin_amdgcn_exp2f(m_reg - mn); m_reg = mn; }
#pragma unroll
  for (int r = 0; r < 16; ++r) { p0[r] -= mn; p1[r] -= mn; }
#pragma unroll
  for (int r = 0; r < 16; ++r) p0[r] = __builtin_amdgcn_exp2f(p0[r]);
}
__device__ __forceinline__ void finishSM(f32x16& p0, f32x16& p1, float alpha, float& l_reg, bf16x8& pa0, bf16x8& pa1, bf16x8& pa2, bf16x8& pa3) {
#pragma unroll
  for (int r = 0; r < 16; ++r) p1[r] = __builtin_amdgcn_exp2f(p1[r]);
  typedef float f32x2_ __attribute__((ext_vector_type(2)));
  f32x2_ ps2 = {0.f, 0.f};
#pragma unroll
  for (int r = 0; r < 16; r += 2) { ps2 += (f32x2_){p0[r], p0[r + 1]}; ps2 += (f32x2_){p1[r], p1[r + 1]}; }
  float ps = ps2.x + ps2.y;
  { auto rr = __builtin_amdgcn_permlane32_swap(__float_as_uint(ps), __float_as_uint(ps), false, false);
    ps = __uint_as_float(rr[0]) + __uint_as_float(rr[1]); }
  l_reg = l_reg * alpha + ps;
#define PK4(P, BASE, OUT) do { unsigned a0 = cvtpk(P[BASE + 0], P[BASE + 1]), a1 = cvtpk(P[BASE + 2], P[BASE + 3]);   \
    unsigned b0 = cvtpk(P[BASE + 4], P[BASE + 5]), b1 = cvtpk(P[BASE + 6], P[BASE + 7]);                              \
    auto r0 = __builtin_amdgcn_permlane32_swap(a0, b0, false, false); auto r1 = __builtin_amdgcn_permlane32_swap(a1, b1, false, false); \
    u32x4 w = {r0[0], r1[0], r0[1], r1[1]}; OUT = *reinterpret_cast<bf16x8*>(&w); } while (0)
  PK4(p0, 0, pa0); PK4(p0, 8, pa1); PK4(p1, 0, pa2); PK4(p1, 8, pa3);
#undef PK4
}
#define ATT_LAS __attribute__((address_space(3)))
template <int ND> __device__ __forceinline__ void qkt(f32x16& p0, f32x16& p1, const ATT_LAS char* Ks, const bf16x8* qr, int r32, int hi, int dbase) {
  p0 = f32x16{}; p1 = f32x16{};
#pragma unroll
  for (int d0 = 0; d0 < ND; ++d0) { int cb = (dbase + d0 * 16 + hi * 8) * 2;
    bf16x8 b0 = *reinterpret_cast<const ATT_LAS bf16x8*>(Ks + KSWZ(r32, cb));
    bf16x8 b1 = *reinterpret_cast<const ATT_LAS bf16x8*>(Ks + KSWZ(32 + r32, cb));
    p0 = __builtin_amdgcn_mfma_f32_32x32x16_bf16(b0, qr[d0], p0, 0, 0, 0);
    p1 = __builtin_amdgcn_mfma_f32_32x32x16_bf16(b1, qr[d0], p1, 0, 0, 0); }
}
__device__ __forceinline__ int v_st(int k, int c) { const int kk = (k & ~0xC) | ((k & 4) << 1) | ((k & 8) >> 1); return ((kk >> 3) * 4 + (c >> 5)) * 512 + ((kk & 7) * 32 + (c & 31)) * 2; }
__device__ __forceinline__ int v_rd_base(int lane) { return ((lane & 3) << 3) | (((lane >> 2) & 3) << 6) | (((lane >> 4) & 1) << 5) | (((lane >> 5) & 1) << 8); }
constexpr int v_rd_off(int d0, int ks, int half) { return d0 * 512 + ks * 4096 + half * 2048; }
template <int OFF> __device__ __forceinline__ s16x4 tr_read(int vb) {
  s16x4 r; asm volatile("ds_read_b64_tr_b16 %0, %1 offset:%2" : "=&v"(r) : "v"(vb), "i"(OFF) : "memory"); return r;
}
template <int D0> __device__ __forceinline__ void pv_one(f32x16& od, int vb, bf16x8 pa0, bf16x8 pa1, bf16x8 pa2, bf16x8 pa3) {
  const s16x4 l0 = tr_read<v_rd_off(D0, 0, 0)>(vb), h0 = tr_read<v_rd_off(D0, 0, 1)>(vb), l1 = tr_read<v_rd_off(D0, 1, 0)>(vb), h1 = tr_read<v_rd_off(D0, 1, 1)>(vb);
  const s16x4 l2 = tr_read<v_rd_off(D0, 2, 0)>(vb), h2 = tr_read<v_rd_off(D0, 2, 1)>(vb), l3 = tr_read<v_rd_off(D0, 3, 0)>(vb), h3 = tr_read<v_rd_off(D0, 3, 1)>(vb);
  asm volatile("s_waitcnt lgkmcnt(0)" ::: "memory"); SBAR();
#define PK(L, H) (bf16x8){L[0], L[1], L[2], L[3], H[0], H[1], H[2], H[3]}
  od = __builtin_amdgcn_mfma_f32_32x32x16_bf16(pa0, PK(l0, h0), od, 0, 0, 0);
  od = __builtin_amdgcn_mfma_f32_32x32x16_bf16(pa1, PK(l1, h1), od, 0, 0, 0);
  od = __builtin_amdgcn_mfma_f32_32x32x16_bf16(pa2, PK(l2, h2), od, 0, 0, 0);
  od = __builtin_amdgcn_mfma_f32_32x32x16_bf16(pa3, PK(l3, h3), od, 0, 0, 0);
#undef PK
}
__device__ __forceinline__ void pv_d0(f32x16* o, int vb, bf16x8 pa0, bf16x8 pa1, bf16x8 pa2, bf16x8 pa3) {
  pv_one<0>(o[0], vb, pa0, pa1, pa2, pa3); pv_one<1>(o[1], vb, pa0, pa1, pa2, pa3); pv_one<2>(o[2], vb, pa0, pa1, pa2, pa3); pv_one<3>(o[3], vb, pa0, pa1, pa2, pa3);
}

__device__ __forceinline__ float sum32(float v) {
#define ATT_ROR(N) v += __uint_as_float((unsigned)__builtin_amdgcn_update_dpp(0, (int)__float_as_uint(v), 0x120 + (N), 0xf, 0xf, false))
  ATT_ROR(8); ATT_ROR(4); ATT_ROR(2); ATT_ROR(1);
#undef ATT_ROR
  auto a = __builtin_amdgcn_permlane16_swap(__float_as_uint(v), __float_as_uint(v), false, false);
  return __uint_as_float(a[0]) + __uint_as_float(a[1]);
}
struct UnitP {
  const bf16_t* Q; int ldq;
  const bf16_t* K; const bf16_t* V; int ldk;
  bf16_t* Y; int ldy;
  int NT, qpos0, qb;
  const float* bias_col;
  const float* km;
  const float* lamp; const float* gsub;
  unsigned* ticket;
};

constexpr int LUT_D0 = 207, LUT_N = 304;
template <int MODE>
__device__ __forceinline__ void score_sm(f32x16& p0, f32x16& p1, int kv0, int qpos, int qwmin, int hi, const ATT_LAS float* lutR, unsigned selmask, int qb, float& m_reg, float& alpha) {
  constexpr float C = ((MODE == 2) ? 0.125f : 0.08838834764831845f) * L2E;
  bool rowsel = true;
  if (MODE == 1) { const int n = kv0 >> 8; rowsel = (n >= qb) || ((selmask >> n) & 1u); }
  const bool above = (MODE != 0) && (kv0 > qwmin + 31);
  const bool farp = (MODE == 0) || above || (qwmin - (kv0 + 63) >= 113);
  if (farp) {
    float add = 0.f;
    if (MODE != 0) add = (rowsel && !above) ? lutR[LUT_D0 - 127] : -INFINITY;
    float pmax = p0[0];
#pragma unroll
    for (int r = 1; r < 16; ++r) pmax = fmaxf(pmax, p0[r]);
#pragma unroll
    for (int r = 0; r < 16; ++r) pmax = fmaxf(pmax, p1[r]);
    { auto rr = __builtin_amdgcn_permlane32_swap(__float_as_uint(pmax), __float_as_uint(pmax), false, false);
      pmax = fmaxf(__uint_as_float(rr[0]), __uint_as_float(rr[1])); }
    const float pm = fmaf(pmax, C, add);
    float mn;
    if (__builtin_expect(__all(pm - m_reg <= THRL), 1)) { mn = m_reg; alpha = 1.f; }
    else { mn = fmaxf(m_reg, pm); alpha = __builtin_amdgcn_exp2f(m_reg - mn); m_reg = mn; }
    const float off = add - mn;
    p0 = p0 * C + off; p1 = p1 * C + off;
#pragma unroll
    for (int r = 0; r < 16; ++r) p0[r] = __builtin_amdgcn_exp2f(p0[r]);
  } else {
    const ATT_LAS float* tb = lutR + (rowsel ? 0 : LUT_N) + (LUT_D0 - (qpos - kv0) + 4 * hi);
#pragma unroll
    for (int r = 0; r < 16; ++r) { const int c = (r & 3) + 8 * (r >> 2); p0[r] = fmaf(p0[r], C, tb[c]); p1[r] = fmaf(p1[r], C, tb[c + 32]); }
    partialSM(p0, p1, m_reg, alpha);
  }
}

template <int MODE>
__device__ __forceinline__ void attn_unit(ATT_LAS unsigned char* L, const UnitP& P) {
  int tid_ = threadIdx.x; asm volatile("" : "+v"(tid_));
  const int tid = tid_, wid = __builtin_amdgcn_readfirstlane(tid >> 6), lane = tid & 63, r32 = lane & 31, hi = lane >> 5;
  const int wq = (MODE == 2) ? (wid & 3) : wid, dsel = (MODE == 2) ? (wid >> 2) : 0;
  constexpr int ND = (MODE == 2) ? 4 : 8;
  const int dbase = dsel * 64;
  ATT_LAS float* ws = (ATT_LAS float*)(L + OFF_WS) + wid * 64; ATT_LAS float* li_l = ws; ATT_LAS float* al_l = ws + 32;
  ATT_LAS float* lut = (ATT_LAS float*)(L + OFF_LUT); ATT_LAS float* kml = (ATT_LAS float*)(L + OFF_KM);
  const bf16_t* Kh = P.K; const bf16_t* Vh = P.V; const int LDK = P.ldk; const int NT = P.NT;
  int ksrc[2], vsrc[2];
#pragma unroll
  for (int i = 0; i < 2; ++i) { const int p = (wid * 2 + i) * 1024 + lane * 16;
    const int row = p >> 8, colB = (p & 255) ^ ((row & 7) << 4); ksrc[i] = row * LDK + (colB >> 1);
    const int sub = p >> 9, w = p & 511, kk = (sub >> 2) * 8 + (w >> 6), k = (kk & ~0xC) | ((kk & 4) << 1) | ((kk & 8) >> 1), c = (sub & 3) * 32 + ((w & 63) >> 1); vsrc[i] = k * LDK + c; }
#define DMA(t, sl) do { const bf16_t* kb_ = Kh + (long)(t) * KVBLK * LDK; const bf16_t* vb_ = Vh + (long)(t) * KVBLK * LDK; \
    _Pragma("unroll") for (int i_ = 0; i_ < 2; ++i_) __builtin_amdgcn_global_load_lds((const unsigned*)(kb_ + ksrc[i_]), (ATT_LAS unsigned*)(L + (sl) + (wid * 2 + i_) * 1024), 16, 0, 0); \
    _Pragma("unroll") for (int i_ = 0; i_ < 2; ++i_) __builtin_amdgcn_global_load_lds((const unsigned*)(vb_ + vsrc[i_]), (ATT_LAS unsigned*)(L + (sl) + 16384 + (wid * 2 + i_) * 1024), 16, 0, 0); } while (0)
  DMA(0, 0); DMA(1, SLOTB); if (2 < NT) DMA(2, 2 * SLOTB);
  const float bfar = 0.f;
  if (MODE != 0) { if (tid < LUT_N) { const int d = LUT_D0 - tid; lut[tid] = d < 0 ? -INFINITY : P.bias_col[bucket(min(d, 127)) * 12] * L2E; lut[LUT_N + tid] = -INFINITY; } }
  if (MODE == 1) { if (P.qb >= 4) for (int i = tid; i < P.qb * 128; i += 512) { const float* kp = P.km + (size_t)((i >> 7) * 4) * 1536 + (i & 127); kml[i] = ((kp[0] + kp[1536]) + (kp[2 * 1536] + kp[3 * 1536])) * (1.0f / 256.0f); } }
  float m_reg = -1e30f, l_reg = 0; f32x16 o[4] = {}; bf16x8 qr[ND];
  const bf16_t* Qw = P.Q + (long)(wq * QBLK + r32) * P.ldq + dbase + hi * 8;
#pragma unroll
  for (int d0 = 0; d0 < ND; ++d0) qr[d0] = *reinterpret_cast<const bf16x8*>(Qw + d0 * 16);
  const int qwmin = P.qpos0 + wq * 32, qpos = qwmin + r32, qb = P.qb;
  constexpr float C = ((MODE == 2) ? 0.125f : 0.08838834764831845f) * L2E;
  const int vb0 = (int)(size_t)(L + 16384) + v_rd_base(lane);
#define RESC(a) do { if (__any((a) < 1.f)) { if (hi == 0) al_l[r32] = (a); asm volatile("s_waitcnt lgkmcnt(0)" ::: "memory"); \
    _Pragma("unroll") for (int d = 0; d < 4; ++d) _Pragma("unroll") for (int r = 0; r < 16; ++r) o[d][r] *= al_l[crow(r, hi)]; } } while (0)
#define XFSM(PX0, PX1, j, AL) score_sm<MODE>(PX0, PX1, (j) * KVBLK, qpos, qwmin, hi, lut, selmask, qb, m_reg, AL)
  f32x16 p0, p1; float al; bf16x8 pa0, pa1, pa2, pa3;
  asm volatile("s_waitcnt vmcnt(0) lgkmcnt(0)\n\ts_barrier" ::: "memory");
  unsigned selmask = 0xFFu;
  if (MODE == 1) { if (qb >= 4) {
    float g[7];
#pragma unroll
    for (int n = 0; n < 7; ++n) { float s = 0.f;
      if (n < qb) {
#pragma unroll
        for (int d0 = 0; d0 < ND; ++d0) { const f32x4 k0 = *(const ATT_LAS f32x4*)&kml[n * 128 + d0 * 16 + hi * 8], k1 = *(const ATT_LAS f32x4*)&kml[n * 128 + d0 * 16 + hi * 8 + 4];
#pragma unroll
          for (int i = 0; i < 4; ++i) { s = fmaf(__uint_as_float(((unsigned)(unsigned short)qr[d0][i]) << 16), k0[i], s); s = fmaf(__uint_as_float(((unsigned)(unsigned short)qr[d0][4 + i]) << 16), k1[i], s); } } }
      { auto rr = __builtin_amdgcn_permlane32_swap(__float_as_uint(s), __float_as_uint(s), false, false); s = __uint_as_float(rr[0]) + __uint_as_float(rr[1]); }
      g[n] = s; }
    selmask = 0u;
#pragma unroll
    for (int n = 0; n < 7; ++n) { int cnt = 0;
#pragma unroll
      for (int m = 0; m < 7; ++m) if (m != n) cnt += (m < qb && (g[m] > g[n] || (g[m] == g[n] && m < n))) ? 1 : 0;
      if (n < qb && cnt < 3) selmask |= (1u << n); }
  } }
  if constexpr (MODE == PIPE_OFF_MODE) {
  int s_cur = 0, s_pre = 3 * SLOTB;
#pragma unroll 1
  for (int j = 0; j < NT; ++j) {
    const bool more2 = j + 3 < NT;
    if (more2) DMA(j + 3, s_pre);
    SBAR(); qkt<ND>(p0, p1, (const ATT_LAS char*)(L + s_cur), qr, r32, hi, dbase);
    XFSM(p0, p1, j, al);
    RESC(al);
    finishSM(p0, p1, al, l_reg, pa0, pa1, pa2, pa3); SBAR();
    pv_d0(o, vb0 + s_cur, pa0, pa1, pa2, pa3);
    if (j + 1 < NT) {
      if (more2) asm volatile("s_waitcnt vmcnt(4) lgkmcnt(0)\n\ts_barrier" ::: "memory");
      else asm volatile("s_waitcnt vmcnt(0) lgkmcnt(0)\n\ts_barrier" ::: "memory");
    }
    s_cur = (s_cur == (NSLOT - 1) * SLOTB) ? 0 : s_cur + SLOTB; s_pre = (s_pre == (NSLOT - 1) * SLOTB) ? 0 : s_pre + SLOTB;
  }
  } else {
  f32x16 pB0, pB1; float alB;
#define SLOT(t) (((t) & 3) * SLOTB)
#define STEP_END(j) do { if ((j) + 1 < NT) { if ((j) + 2 < NT) asm volatile("s_waitcnt vmcnt(4) lgkmcnt(0)\n\ts_barrier" ::: "memory"); else asm volatile("s_waitcnt vmcnt(0) lgkmcnt(0)\n\ts_barrier" ::: "memory"); } } while (0)
  qkt<ND>(p0, p1, (const ATT_LAS char*)(L + SLOT(0)), qr, r32, hi, dbase); XFSM(p0, p1, 0, al);
#pragma unroll 1
  for (int j = 1; j < NT; j += 2) {
    if (j + 2 < NT) DMA(j + 2, SLOT(j + 2));
    SBAR(); qkt<ND>(pB0, pB1, (const ATT_LAS char*)(L + SLOT(j)), qr, r32, hi, dbase);
    finishSM(p0, p1, al, l_reg, pa0, pa1, pa2, pa3); SBAR();
    pv_d0(o, vb0 + SLOT(j - 1), pa0, pa1, pa2, pa3); XFSM(pB0, pB1, j, alB);
    RESC(alB);
    STEP_END(j);
    if (j + 1 < NT) {
      if (j + 3 < NT) DMA(j + 3, SLOT(j + 3));
      SBAR(); qkt<ND>(p0, p1, (const ATT_LAS char*)(L + SLOT(j + 1)), qr, r32, hi, dbase);
      finishSM(pB0, pB1, alB, l_reg, pa0, pa1, pa2, pa3); SBAR();
      pv_d0(o, vb0 + SLOT(j), pa0, pa1, pa2, pa3); XFSM(p0, p1, j + 1, al);
      RESC(al);
      STEP_END(j + 1);
    }
  }
  finishSM(pB0, pB1, alB, l_reg, pa0, pa1, pa2, pa3); SBAR();
  pv_d0(o, vb0 + SLOT(NT - 1), pa0, pa1, pa2, pa3);
#undef SLOT
#undef STEP_END
  }
  unsigned nticket = 0u; if (tid == 0) nticket = atomicAdd(P.ticket, 1u);
  if (hi == 0) li_l[r32] = l_reg; asm volatile("s_waitcnt lgkmcnt(0)" ::: "memory");
  float rli[16];
#pragma unroll
  for (int r = 0; r < 16; ++r) rli[r] = __builtin_amdgcn_rcpf(li_l[crow(r, hi)]);
  bf16_t* Yw = P.Y + (long)(wq * QBLK) * P.ldy;
  if (MODE != 2) {
#pragma unroll
    for (int r = 0; r < 16; r += 2) { const int orow = crow(r, hi);
#pragma unroll
      for (int d0 = 0; d0 < 4; ++d0) { const unsigned w = cvtpk(o[d0][r] * rli[r], o[d0][r + 1] * rli[r + 1]);
        Yw[(long)orow * P.ldy + d0 * 32 + r32] = (unsigned short)(w & 0xffffu); Yw[(long)(orow + 1) * P.ldy + d0 * 32 + r32] = (unsigned short)(w >> 16); } }
    if (tid == 0) *(volatile ATT_LAS unsigned*)(L + OFF_MISC) = nticket;
    __syncthreads();
  } else {
    ATT_LAS f32x4* exch = (ATT_LAS f32x4*)(L + (wid & 3) * 17408) + lane * 17;
    __syncthreads();
    if (dsel == 1) { const float lam = P.lamp[0];
#pragma unroll
      for (int r = 0; r < 16; ++r) { const float f = rli[r] * lam; exch[r] = (f32x4){o[0][r] * f, o[1][r] * f, o[2][r] * f, o[3][r] * f}; }
    }
    __syncthreads();
    if (dsel == 0) {
      float gs[4];
#pragma unroll
      for (int d0 = 0; d0 < 4; ++d0) gs[d0] = P.gsub[d0 * 32 + r32];
      f32x4 ex[16];
#pragma unroll
      for (int r = 0; r < 16; ++r) ex[r] = exch[r];
      const float osc = P.lamp[2];
#pragma unroll
      for (int r = 0; r < 16; r += 2) {
        float v0[4], v1[4], s0 = 0.f, s1 = 0.f;
#pragma unroll
        for (int d0 = 0; d0 < 4; ++d0) { v0[d0] = o[d0][r] * rli[r] - ex[r][d0]; s0 = fmaf(v0[d0], v0[d0], s0); v1[d0] = o[d0][r + 1] * rli[r + 1] - ex[r + 1][d0]; s1 = fmaf(v1[d0], v1[d0], s1); }
        s0 = rsqrtf(sum32(s0) * (1.0f / 128.0f) + 1e-6f) * osc; s1 = rsqrtf(sum32(s1) * (1.0f / 128.0f) + 1e-6f) * osc;
        const int orow = crow(r, hi);
#pragma unroll
        for (int d0 = 0; d0 < 4; ++d0) { const unsigned w = cvtpk(v0[d0] * s0 * gs[d0], v1[d0] * s1 * gs[d0]);
          Yw[(long)orow * P.ldy + d0 * 32 + r32] = (unsigned short)(w & 0xffffu); Yw[(long)(orow + 1) * P.ldy + d0 * 32 + r32] = (unsigned short)(w >> 16); } }
    }
    if (tid == 0) *(volatile ATT_LAS unsigned*)(L + OFF_MISC) = nticket;
    __syncthreads();
  }
#undef DMA
#undef RESC
#undef XFSM
}
}

constexpr int DM = 2048, NB = 4, SEQ = 2048, NTOK = NB * SEQ, DEPTH = 4, HD = 128, NSH = 12, NMH = 4, SW = 1536, MW = 512, NMEM = 256, NMTOK = NB * NMEM;
constexpr int DFF = 5632, NINA = 3 * SW + MW  , NINB = SW + MW  , NKV = 2 * SW  , NGU = 2 * DFF  , NMKV = 2 * MW  ;
constexpr float RMS_EPS = 1e-6f;
constexpr size_t MiB = 1u << 20;
constexpr size_t WS_CTL = 0, WS_WINA = 1 * MiB, WS_WINB = 41 * MiB, WS_WMEM = 57 * MiB, WS_WO = 73 * MiB, WS_WGU = 105 * MiB, WS_WDN = 281 * MiB, WS_WKV = 369 * MiB;
constexpr size_t WS_H = 381 * MiB, WS_XN = 445 * MiB, WS_XKV = 477 * MiB, WS_MN = 509 * MiB, WS_MKV = 525 * MiB, WS_PROJ = 533 * MiB, WS_KVS = 613 * MiB, WS_Y = 661 * MiB, WS_ACT = 693 * MiB, WS_KM = 781 * MiB, WS_H2 = 782 * MiB, WS_SS = 846 * MiB, WS_END = 848 * MiB;
static_assert(WS_WINB - WS_WINA >= (size_t)2 * NINA * DM * 2 && WS_WGU - WS_WO >= (size_t)4 * DM * DM * 2 && WS_WDN - WS_WGU >= (size_t)4 * NGU * DM * 2 && WS_WKV - WS_WDN >= (size_t)4 * DM * DFF * 2 && WS_H - WS_WKV >= (size_t)NKV * DM * 2, "ws map (weights)");
static_assert(WS_XN - WS_H >= (size_t)NTOK * DM * 4 && WS_KVS - WS_PROJ >= (size_t)NTOK * NINA * 2 && WS_Y - WS_KVS >= (size_t)NTOK * NKV * 2 && WS_KM - WS_ACT >= (size_t)NTOK * DFF * 2, "ws map (activations)");
constexpr int LDS_BYTES = 143360;

#define LAS __attribute__((address_space(3)))
typedef unsigned short bf16_t;
typedef float f32x4 __attribute__((ext_vector_type(4)));
typedef unsigned v4u __attribute__((ext_vector_type(4)));
__device__ __forceinline__ unsigned f2bf_u(float f) { unsigned u = __builtin_bit_cast(unsigned, f); return (u + 0x7fffu + ((u >> 16) & 1u)) >> 16; }
__device__ __forceinline__ unsigned pk2(float lo, float hi) { return f2bf_u(lo) | (f2bf_u(hi) << 16); }
__device__ __forceinline__ float wave_sum(float v) {
#pragma unroll
  for (int o = 1; o < 64; o <<= 1) v += __shfl_xor(v, o);
  return v;
}
#define XB_TMO      128
#define XB_XCNT(j)  (256  + 64 * (j))
#define XB_XSUB(j)  (1280 + 64 * (j))
#define XB_XGEN(j)  (2304 + 64 * (j))
#define XB_TOP      3328
#define XB_TOPGEN   3392
#define XCD_BAR_WORDS 3456
#define XB_SPIN_CAP (1u << 18)

__device__ __forceinline__ unsigned xb_ld(unsigned* p)              { return __hip_atomic_load(p, __ATOMIC_RELAXED, __HIP_MEMORY_SCOPE_AGENT); }
__device__ __forceinline__ unsigned xb_add(unsigned* p, unsigned v) { return __hip_atomic_fetch_add(p, v, __ATOMIC_RELAXED, __HIP_MEMORY_SCOPE_AGENT); }
__device__ __forceinline__ unsigned xb_xcc_id() { return (unsigned)__builtin_amdgcn_s_getreg((3 << 11) | 20) & 0xFu; }
#define XB_SPIN(cond, bar) do { unsigned _sp = 0; while (cond) { __builtin_amdgcn_s_sleep(1); \
    if ((++_sp & 255u) == 0u) { if (xb_ld(&(bar)[XB_TMO])) break; if (_sp > XB_SPIN_CAP) { atomicAdd(&(bar)[XB_TMO], 1u); break; } } } } while (0)

struct XcdBarrier {
    unsigned* bar; unsigned x;
    volatile LAS unsigned* st;
};

__device__ __forceinline__ XcdBarrier xcd_barrier_post(unsigned* bar, volatile LAS unsigned* st) {
    XcdBarrier b; b.bar = bar; b.x = xb_xcc_id(); b.st = st;
    if (threadIdx.x == 0) (void)xb_add(&bar[XB_XCNT(b.x)], 1u);
    return b;
}
__device__ __forceinline__ void xcd_barrier_complete(unsigned* bar, unsigned x, unsigned& nloc, unsigned& nx) {
    const unsigned G = gridDim.x * gridDim.y * gridDim.z;
    unsigned sum, cnt, mine, sp = 0u;
    for (;;) {
        sum = 0u; cnt = 0u; mine = 0u;
#pragma unroll
        for (unsigned j = 0; j < 16; ++j) { const unsigned c = xb_ld(&bar[XB_XCNT(j)]); sum += c; cnt += (c > 0u) ? 1u : 0u; mine = (j == x) ? c : mine; }
        if (sum == G) break;
        __builtin_amdgcn_s_sleep(1);
        if ((++sp & 255u) == 0u) { if (xb_ld(&bar[XB_TMO])) break; if (sp > XB_SPIN_CAP) { atomicAdd(&bar[XB_TMO], 1u); break; } }
    }
    nloc = mine > 0u ? mine : 1u; nx = cnt > 0u ? cnt : 1u;
}

__device__ __forceinline__ void xcd_barrier(const XcdBarrier& b) {
    asm volatile("s_waitcnt vmcnt(0)" ::: "memory");
    __syncthreads();
    if (threadIdx.x == 0) {
        unsigned* bar = b.bar;
        __builtin_amdgcn_s_waitcnt(0);
        unsigned nloc = b.st[0], nx = b.st[1];
        if (nloc == 0u) { xcd_barrier_complete(bar, b.x, nloc, nx); b.st[0] = nloc; b.st[1] = nx; }
        const unsigned old = xb_add(&bar[XB_XSUB(b.x)], 1u);
        const unsigned gen = old / nloc;
        if (old + 1u == (gen + 1u) * nloc) {
            __builtin_amdgcn_fence(__ATOMIC_RELEASE, "agent");
            asm volatile("s_waitcnt vmcnt(0)" ::: "memory");
            const unsigned og = xb_add(&bar[XB_TOP], 1u);
            const unsigned tg = og / nx;
            if (og + 1u == (tg + 1u) * nx) xb_add(&bar[XB_TOPGEN], 1u);
            else XB_SPIN(xb_ld(&bar[XB_TOPGEN]) == tg, bar);
            __builtin_amdgcn_fence(__ATOMIC_ACQUIRE, "agent");
            xb_add(&bar[XB_XGEN(b.x)], 1u);
            asm volatile("s_waitcnt vmcnt(0)" ::: "memory");
        } else {
            XB_SPIN(xb_ld(&bar[XB_XGEN(b.x)]) == gen, bar);
            __builtin_amdgcn_fence(__ATOMIC_ACQUIRE, "agent");
            asm volatile("s_waitcnt vmcnt(0)" ::: "memory");
        }
    }
    __syncthreads();
}

__device__ __forceinline__ void transpose_item(const float* W, int K, int N, bf16_t* WT, bool gu, LAS float* scr, int item, int lane, const float* gk = nullptr) {
  const int nblk = N / 64, kb = item / nblk, nb = item % nblk, k0 = 64 * kb, n0 = 64 * nb;
  int nr0 = n0;
  if (gu) { const int half = n0 >= DFF, np = n0 - half * DFF; nr0 = (np >> 7) * 256 + half * 128 + (np & 127); }
#pragma unroll 16
  for (int i = 0; i < 64; ++i) scr[i * 65 + lane] = __builtin_nontemporal_load(&W[(size_t)(k0 + i) * N + n0 + lane]);
  asm volatile("s_waitcnt lgkmcnt(0)" ::: "memory");
  const int c = lane & 7;
  f32x4 ga = {1.f, 1.f, 1.f, 1.f}, gb = {1.f, 1.f, 1.f, 1.f};
  if (gk) { ga = *(const f32x4*)(gk + k0 + 8 * c); gb = *(const f32x4*)(gk + k0 + 8 * c + 4); }
#pragma unroll
  for (int j = 0; j < 8; ++j) { const int n = (lane >> 3) + 8 * j; const LAS float* s = scr + (8 * c) * 65 + n;
    v4u o; o.x = pg8::cvt_pk_bf16(s[0 * 65] * ga[0], s[1 * 65] * ga[1]); o.y = pg8::cvt_pk_bf16(s[2 * 65] * ga[2], s[3 * 65] * ga[3]); o.z = pg8::cvt_pk_bf16(s[4 * 65] * gb[0], s[5 * 65] * gb[1]); o.w = pg8::cvt_pk_bf16(s[6 * 65] * gb[2], s[7 * 65] * gb[3]);
    __builtin_nontemporal_store(o, (v4u*)(WT + (size_t)(nr0 + n) * K + k0 + 8 * c)); }
  asm volatile("s_waitcnt lgkmcnt(0)" ::: "memory");
}
__device__ __forceinline__ void rms_row(const float* xrow, int lane, const float* g0, bf16_t* o0, const float* g1, bf16_t* o1, float* fo) {
  const f32x4* xr = (const f32x4*)xrow + lane;
  f32x4 v[8]; float s = 0.f;
#pragma unroll
  for (int j = 0; j < 8; ++j) { v[j] = xr[64 * j]; s += (v[j].x * v[j].x + v[j].y * v[j].y) + (v[j].z * v[j].z + v[j].w * v[j].w); }
  const float r = rsqrtf(wave_sum(s) * (1.0f / DM) + RMS_EPS);
#pragma unroll
  for (int j = 0; j < 8; ++j) {
    const f32x4 gv = ((const f32x4*)g0)[lane + 64 * j]; const f32x4 y = v[j] * r * gv;
    if (fo) ((f32x4*)fo)[lane + 64 * j] = y;
    else ((unsigned long long*)o0)[lane + 64 * j] = (unsigned long long)pk2(y.x, y.y) | ((unsigned long long)pk2(y.z, y.w) << 32);
    if (g1) { const f32x4 g2 = ((const f32x4*)g1)[lane + 64 * j]; const f32x4 y2 = v[j] * r * g2;
      ((unsigned long long*)o1)[lane + 64 * j] = (unsigned long long)pk2(y2.x, y2.y) | ((unsigned long long)pk2(y2.z, y2.w) << 32); }
  }
}

template <int R>
__device__ __forceinline__ void rms_rows(const float* X, int m0, int mstride, int mend, int lane, const float* g0, bf16_t* o0, float* fo) {
  f32x4 v[R][8];
#pragma unroll
  for (int i = 0; i < R; ++i) { const int m = m0 + i * mstride; if (m < mend) { const f32x4* xr = (const f32x4*)(X + (size_t)m * DM) + lane;
#pragma unroll
      for (int j = 0; j < 8; ++j) v[i][j] = xr[64 * j]; } }
#pragma unroll
  for (int i = 0; i < R; ++i) { const int m = m0 + i * mstride; if (m < mend) { float s = 0.f;
#pragma unroll
      for (int j = 0; j < 8; ++j) s += (v[i][j].x * v[i][j].x + v[i][j].y * v[i][j].y) + (v[i][j].z * v[i][j].z + v[i][j].w * v[i][j].w);
      const float r = rsqrtf(wave_sum(s) * (1.0f / DM) + RMS_EPS);
#pragma unroll
      for (int j = 0; j < 8; ++j) { const f32x4 gv = g0 ? ((const f32x4*)g0)[lane + 64 * j] : (f32x4){1.f, 1.f, 1.f, 1.f}; const f32x4 y = v[i][j] * r * gv;
        if (fo) ((f32x4*)(fo + (size_t)m * DM))[lane + 64 * j] = y;
        else ((unsigned long long*)(o0 + (size_t)m * DM))[lane + 64 * j] = (unsigned long long)pk2(y.x, y.y) | ((unsigned long long)pk2(y.z, y.w) << 32); } } }
}
template <int R>
__device__ __forceinline__ void rms_rows_h(const bf16_t* X, int m0, int mstride, int mend, int lane, const float* g0, float* fo) {
  v4u v[R][4];
#pragma unroll
  for (int i = 0; i < R; ++i) { const int m = m0 + i * mstride; if (m < mend) { const v4u* xr = (const v4u*)(X + (size_t)m * DM) + lane;
#pragma unroll
      for (int j = 0; j < 4; ++j) v[i][j] = xr[64 * j]; } }
#pragma unroll
  for (int i = 0; i < R; ++i) { const int m = m0 + i * mstride; if (m < mend) { float s = 0.f;
#pragma unroll
      for (int j = 0; j < 4; ++j)
#pragma unroll
        for (int e = 0; e < 4; ++e) { const float a = __uint_as_float(v[i][j][e] << 16), b = __uint_as_float(v[i][j][e] & 0xffff0000u); s += a * a + b * b; }
      const float r = rsqrtf(wave_sum(s) * (1.0f / DM) + RMS_EPS);
#pragma unroll
      for (int j = 0; j < 4; ++j) { const int c0 = (lane + 64 * j) * 8; const f32x4 ga = *(const f32x4*)(g0 + c0), gb = *(const f32x4*)(g0 + c0 + 4);
        const f32x4 ya = (f32x4){__uint_as_float(v[i][j][0] << 16), __uint_as_float(v[i][j][0] & 0xffff0000u), __uint_as_float(v[i][j][1] << 16), __uint_as_float(v[i][j][1] & 0xffff0000u)} * r * ga;
        const f32x4 yb = (f32x4){__uint_as_float(v[i][j][2] << 16), __uint_as_float(v[i][j][2] & 0xffff0000u), __uint_as_float(v[i][j][3] << 16), __uint_as_float(v[i][j][3] & 0xffff0000u)} * r * gb;
        *(f32x4*)(fo + (size_t)m * DM + c0) = ya; *(f32x4*)(fo + (size_t)m * DM + c0 + 4) = yb; } } }
}
struct Args { const float* in[17]; float* out; unsigned char* ws; int ph_lo, ph_hi; };
constexpr int N_PHASES = 1 + 8 * DEPTH;

__global__ void __launch_bounds__(512, 2) fwd(Args a) {
  extern __shared__ __attribute__((aligned(16))) unsigned char lds[];
  cg::grid_group grid = cg::this_grid();
  const int wave = __builtin_amdgcn_readfirstlane((int)threadIdx.x >> 6), G = gridDim.x, bid = blockIdx.x;
  const int gw = bid * 8 + wave, NGW = G * 8;
  const int lo = a.ph_lo, hiP = a.ph_hi;
#ifndef REP_CLASS
#define REP_CLASS -1
#endif
#define REPS(k) ((REP_CLASS == (k)) ? 2 : 1)
#define RUN(k) (lo <= (k) && (k) < hiP)
#define GSYNC() xcd_barrier(xbar)
#define SEAM(k) do { if (RUN(k) && RUN((k) + 1)) GSYNC(); } while (0)
#define PHASE_BEGIN const __attribute__((address_space(4))) Args* ka = (const __attribute__((address_space(4))) Args*)__builtin_amdgcn_kernarg_segment_ptr(); asm volatile("" : "+s"(ka)); unsigned char* ws = ka->ws; int tid = threadIdx.x; asm volatile("" : "+v"(tid)); const int lane = tid & 63; (void)lane; (void)ws; \
  unsigned* ctl = (unsigned*)(ws + WS_CTL); (void)ctl;
#define X_IN (ka->in[0])
#define MEM_IN (ka->in[1])
#define rel_bias (ka->in[2])
#define g_mix (ka->in[3])
#define w_in_a (ka->in[4])
#define w_in_b (ka->in[5])
#define g_mem (ka->in[6])
#define w_mem_kv (ka->in[7])
#define w_o (ka->in[8])
#define g_ffn (ka->in[9])
#define w_gate_up (ka->in[10])
#define w_down (ka->in[11])
#define g_kv (ka->in[12])
#define w_kv_shared (ka->in[13])
#define lambda_qk (ka->in[14])
#define g_subln (ka->in[15])
#define g_final (ka->in[16])
#define WINA ((bf16_t*)(ws + WS_WINA))
#define WINB ((bf16_t*)(ws + WS_WINB))
#define WMEM ((bf16_t*)(ws + WS_WMEM))
#define WO ((bf16_t*)(ws + WS_WO))
#define WGU ((bf16_t*)(ws + WS_WGU))
#define WDN ((bf16_t*)(ws + WS_WDN))
#define WKV ((bf16_t*)(ws + WS_WKV))
#define HB ((bf16_t*)(ws + WS_H))
#define HB2 ((bf16_t*)(ws + WS_H2))
#define XN ((bf16_t*)(ws + WS_XN))
#define XKV ((bf16_t*)(ws + WS_XKV))
#define MN ((bf16_t*)(ws + WS_MN))
#define MKV ((bf16_t*)(ws + WS_MKV))
#define PROJ ((bf16_t*)(ws + WS_PROJ))
#define KVS ((bf16_t*)(ws + WS_KVS))
#define YB ((bf16_t*)(ws + WS_Y))
#define ACT ((bf16_t*)(ws + WS_ACT))
#define KM ((float*)(ws + WS_KM))
#define SSB ((float*)(ws + WS_SS))
#define RSL ((LAS float*)(ldsL + 131072))
  LAS unsigned char* ldsL = (LAS unsigned char*)lds;
  { volatile LAS unsigned* st0 = (volatile LAS unsigned*)(ldsL + LDS_BYTES - 16); if (threadIdx.x < 2) st0[threadIdx.x] = 0u; }
  __syncthreads();
#if MK_N_LAUNCHES == 1
  XcdBarrier xbar; xbar.bar = (unsigned*)(a.ws + WS_CTL) + 4096; xbar.x = 0; xbar.st = (volatile LAS unsigned*)(ldsL + LDS_BYTES - 16);
  if (blockIdx.x == 0) for (int i = threadIdx.x; i < XCD_BAR_WORDS; i += 512) __hip_atomic_store(xbar.bar + i, 0u, __ATOMIC_RELAXED, __HIP_MEMORY_SCOPE_AGENT);
#else
  XcdBarrier xbar = xcd_barrier_post((unsigned*)(a.ws + WS_CTL) + 4096, (volatile LAS unsigned*)(ldsL + LDS_BYTES - 16));
#endif

  for (int rep = 0; rep < REPS(0); ++rep) {
  if (RUN(0)) { PHASE_BEGIN
    if (bid == 0 && tid < 8) __hip_atomic_store(ctl + tid, 0u, __ATOMIC_RELAXED, __HIP_MEMORY_SCOPE_AGENT);
    if (bid == 0 && tid >= 64 && tid < 66) { const int j = tid - 64; const float* lq = lambda_qk + j * 256; float s1 = 0.f, s2 = 0.f;
      for (int i = 0; i < 64; ++i) { s1 += lq[i] * lq[64 + i]; s2 += lq[128 + i] * lq[192 + i]; }
      const float lam_init = 0.8f - 0.6f * expf(-0.3f * (float)(2 + j)); ((float*)ctl)[16 + j] = expf(s1) - expf(s2) + lam_init; ((float*)ctl)[18 + j] = 1.0f - lam_init; }
    LAS float* scr = (LAS float*)(ldsL + wave * 16640);
    constexpr int I_INA = (DM / 64) * (NINA / 64), I_INB = (DM / 64) * (NINB / 64), I_MEM = (DM / 64) * (NMKV / 64), I_O = (DM / 64) * (DM / 64), I_GU = (DM / 64) * (NGU / 64), I_DN = (DFF / 64) * (DM / 64), I_KV = (DM / 64) * (NKV / 64);
    constexpr int NITEMS = 2 * I_INA + 2 * I_INB + 4 * I_MEM + 4 * I_O + 4 * I_GU + 4 * I_DN + I_KV;
    for (int it = gw; it < NITEMS; it += NGW) {
      int r = it;
      if (r < 4 * I_GU) { const int l = r / I_GU; transpose_item(w_gate_up + (size_t)l * DM * NGU, DM, NGU, WGU + (size_t)l * NGU * DM, true, scr, r % I_GU, lane, g_ffn + l * DM); continue; } r -= 4 * I_GU;
      if (r < 4 * I_DN) { const int l = r / I_DN; transpose_item(w_down + (size_t)l * DFF * DM, DFF, DM, WDN + (size_t)l * DM * DFF, false, scr, r % I_DN, lane); continue; } r -= 4 * I_DN;
      if (r < 2 * I_INA) { const int l = r / I_INA; transpose_item(w_in_a + (size_t)l * DM * NINA, DM, NINA, WINA + (size_t)l * NINA * DM, false, scr, r % I_INA, lane, g_mix + l * DM); continue; } r -= 2 * I_INA;
      if (r < 2 * I_INB) { const int l = r / I_INB; transpose_item(w_in_b + (size_t)l * DM * NINB, DM, NINB, WINB + (size_t)l * NINB * DM, false, scr, r % I_INB, lane, g_mix + (2 + l) * DM); continue; } r -= 2 * I_INB;
      if (r < 4 * I_MEM) { const int l = r / I_MEM; transpose_item(w_mem_kv + (size_t)l * DM * NMKV, DM, NMKV, WMEM + (size_t)l * NMKV * DM, false, scr, r % I_MEM, lane, g_mem + l * DM); continue; } r -= 4 * I_MEM;
      if (r < 4 * I_O) { const int l = r / I_O; transpose_item(w_o + (size_t)l * DM * DM, DM, DM, WO + (size_t)l * DM * DM, false, scr, r % I_O, lane); continue; } r -= 4 * I_O;
      transpose_item(w_kv_shared, DM, NKV, WKV, false, scr, r, lane, g_kv);
    }
    for (int m = gw; m < NTOK; m += 4 * NGW) rms_rows<4>(X_IN, m, NGW, NTOK, lane, nullptr, XN, nullptr);
    for (int m = gw; m < NMTOK; m += 2 * NGW) rms_rows<2>(MEM_IN, m, NGW, NMTOK, lane, nullptr, MN, nullptr);
    __syncthreads();
  }
  if (RUN(0) && RUN(1)) { if (rep == 0) { grid.sync();
#if MK_N_LAUNCHES == 1
      xbar = xcd_barrier_post((unsigned*)(a.ws + WS_CTL) + 4096, (volatile LAS unsigned*)(ldsL + LDS_BYTES - 16));
#endif
    } else GSYNC(); }
  }

#pragma unroll 1
  for (int l = 0; l < DEPTH; ++l) {
    const int pb = 1 + 8 * l; const bool moba = l < 2; const int j = l - 2;
    const int ldp = moba ? NINA : NINB;
    for (int rep = 0; rep < REPS(1); ++rep) {
    if (RUN(pb)) { PHASE_BEGIN
      const int ng = 1 + (l == 0 ? 4 : 0) + (l == 2 ? 1 : 0);
#pragma unroll 1
      for (int gi = 0; gi < ng; ++gi) {
        pg8::Gemm g; pg8::EpiBf16S E{nullptr, 0, nullptr, nullptr}; int coff = 0; const float* ssp = nullptr;
        if (gi == 0) { g = pg8::Gemm{l == 0 ? XN : HB, moba ? WINA + (size_t)l * NINA * DM : WINB + (size_t)j * NINB * DM, NTOK, ldp, DM}; E.O = PROJ; E.ldc = ldp; if (l > 0) ssp = SSB; if (moba) E.kmp = KM; }
        else if (l == 0) { const int ml = gi - 1; g = pg8::Gemm{MN, WMEM + (size_t)ml * NMKV * DM, NMTOK, NMKV, DM}; E.O = MKV + (size_t)ml * NMTOK * NMKV; E.ldc = NMKV; coff = 128 + 16 * ml; }
        else { g = pg8::Gemm{HB, WKV, NTOK, NKV, DM}; E.O = KVS; E.ldc = NKV; ssp = SSB; }
        if (ssp) E.rs = RSL;
        pg8::RsOrder S; S.so.init(g.M, g.N, G, (bid + G - (coff % G)) % G); S.ss = ssp; S.rs = RSL; S.so.allow_half = (l > 0) ? 1 : 0; S.build();
        pg8::gemm_phase<pg8::EpiBf16S, pg8::RsOrder, true, true>(ldsL, g, S, E);
      }
    }
    SEAM(pb);
    }
    for (int rep = 0; rep < REPS(3); ++rep) {
    if (RUN(pb + 2)) { PHASE_BEGIN
      volatile unsigned* misc = (volatile unsigned*)(lds + att::OFF_MISC);
      const int nself = moba ? NB * NSH * 8 : NB * NSH * 16, NU = nself + NB * NMH * 8;
      if (tid == 0) misc[0] = atomicAdd(ctl + l + 4 * rep, 1u);
      __syncthreads();
      for (;;) {
        const int u = (int)misc[0];
        __syncthreads();
        if (u >= NU) break;
        att::UnitP P; P.bias_col = rel_bias; P.km = nullptr; P.lamp = nullptr; P.gsub = nullptr; P.qb = 0; P.ldy = DM; P.ticket = ctl + l + 4 * rep;
        if (u < nself) {
          const int idx = u % 48, b = idx / NSH, h = idx % NSH; P.bias_col = rel_bias + h;
          if (moba) { const int qb = 7 - u / 48;
            P.Q = PROJ + (size_t)(b * SEQ + qb * 256) * NINA + h * HD; P.ldq = NINA; P.K = PROJ + (size_t)(b * SEQ) * NINA + SW + h * HD; P.V = P.K + SW; P.ldk = NINA;
            P.Y = YB + (size_t)(b * SEQ + qb * 256) * DM + h * HD; P.NT = 4 * (qb + 1); P.qpos0 = qb * 256; P.qb = qb; P.km = KM + (size_t)(b * 8) * 4 * 1536 + h * HD;
            att::attn_unit<1>(ldsL, P);
          } else { const int qt = 15 - u / 48;
            P.Q = PROJ + (size_t)(b * SEQ + qt * 128) * NINB + h * HD; P.ldq = NINB; P.K = KVS + (size_t)(b * SEQ) * NKV + h * HD; P.V = P.K + SW; P.ldk = NKV;
            P.Y = YB + (size_t)(b * SEQ + qt * 128) * DM + h * HD; P.NT = 2 * (qt + 1); P.qpos0 = qt * 128;
            P.lamp = (const float*)ctl + 16 + j; P.gsub = g_subln + j * HD;
            att::attn_unit<2>(ldsL, P);
          }
        } else {
          const int m = u - nself, b = m >> 5, hm = (m >> 3) & 3, qb = m & 7;
          P.Q = PROJ + (size_t)(b * SEQ + qb * 256) * ldp + (ldp - MW) + hm * HD; P.ldq = ldp;
          P.K = MKV + (size_t)l * NMTOK * NMKV + (size_t)(b * NMEM) * NMKV + hm * HD; P.V = P.K + MW; P.ldk = NMKV;
          P.Y = YB + (size_t)(b * SEQ + qb * 256) * DM + SW + hm * HD; P.NT = 4; P.qpos0 = 0;
          att::attn_unit<0>(ldsL, P);
        }
      }
    }
    SEAM(pb + 2);
    }
    for (int rep = 0; rep < REPS(4); ++rep) {
    if (RUN(pb + 3)) { PHASE_BEGIN
      pg8::Gemm g{YB, WO + (size_t)l * DM * DM, NTOK, DM, DM}; pg8::EpiResid E{l == 0 ? X_IN : nullptr, HB, HB2, DM, SSB};
      pg8::StaticOrder S; S.init(NTOK, DM, G, bid);
      pg8::gemm_phase<pg8::EpiResid, pg8::StaticOrder, false, true>(ldsL, g, S, E);
    }
    SEAM(pb + 3);
    }
    for (int rep = 0; rep < REPS(6); ++rep) {
    if (RUN(pb + 5)) { PHASE_BEGIN
      pg8::Gemm g{HB2, WGU + (size_t)l * NGU * DM, NTOK, NGU, DM}; pg8::EpiSwiGLU E{ACT, DFF, RSL};
      pg8::RsOrder S; S.so.init(NTOK, NGU, G, bid); S.ss = SSB; S.rs = RSL; S.so.allow_half = 1; S.build();
      pg8::gemm_phase<pg8::EpiSwiGLU, pg8::RsOrder, true, true>(ldsL, g, S, E);
    }
    SEAM(pb + 5);
    }
    for (int rep = 0; rep < REPS(7); ++rep) {
    if (RUN(pb + 6)) { PHASE_BEGIN
      pg8::Gemm g{ACT, WDN + (size_t)l * DM * DFF, NTOK, DM, DFF}; pg8::EpiResid E{nullptr, HB2, HB, DM, l < DEPTH - 1 ? SSB : nullptr};
      pg8::StaticOrder S; S.init(NTOK, DM, G, bid);
      pg8::gemm_phase<pg8::EpiResid, pg8::StaticOrder, false, true>(ldsL, g, S, E);
    }
    if (RUN(pb + 6) && (l == DEPTH - 1 ? RUN(pb + 7) : RUN(pb + 8))) GSYNC();
    }
    for (int rep = 0; rep < REPS(8); ++rep) {
    if (RUN(pb + 7) && l == DEPTH - 1) { PHASE_BEGIN
      for (int m = gw; m < NTOK; m += 4 * NGW) rms_rows_h<4>(HB, m, NGW, NTOK, lane, g_final, ka->out);
    }
    }
  }
#undef RUN
#undef SEAM
}

extern "C" void kernel_launch(void* const* d_in, const int* in_sizes, int n_in, void* d_out, int out_size, void* d_ws, size_t ws_size, hipStream_t stream) {
  static int grid = 0;
  if (grid == 0) {
    if (n_in != 17 || in_sizes[0] != NTOK * DM || out_size != NTOK * DM || ws_size < WS_END) { fprintf(stderr, "kernel_launch: unexpected shapes (n_in %d, in0 %d, out %d, ws %zu)\n", n_in, n_in > 0 ? in_sizes[0] : -1, out_size, ws_size); grid = -1; return; }
    int dev = 0, cus = 0, per_cu = 0;
    if (hipGetDevice(&dev) != hipSuccess || hipDeviceGetAttribute(&cus, hipDeviceAttributeMultiprocessorCount, dev) != hipSuccess) { grid = -1; return; }
    if (hipFuncSetAttribute((const void*)fwd, hipFuncAttributeMaxDynamicSharedMemorySize, LDS_BYTES) != hipSuccess) { fprintf(stderr, "kernel_launch: hipFuncSetAttribute failed\n"); grid = -1; return; }
    if (hipOccupancyMaxActiveBlocksPerMultiprocessor(&per_cu, (const void*)fwd, 512, LDS_BYTES) != hipSuccess || per_cu < 1) { fprintf(stderr, "kernel_launch: occupancy query says %d\n", per_cu); per_cu = 1; }
    (void)hipGetLastError();
    grid = cus * 1;
  }
  if (grid < 0) return;
#if MK_N_LAUNCHES != 1
  if (hipMemsetAsync((char*)d_ws + WS_CTL, 0, 65536, stream) != hipSuccess) { fprintf(stderr, "kernel_launch: memset failed\n"); return; }
#endif
  Args a{};
  for (int i = 0; i < 17; ++i) a.in[i] = (const float*)d_in[i];
  a.out = (float*)d_out; a.ws = (unsigned char*)d_ws;
#if MK_N_LAUNCHES == 1
  a.ph_lo = 0; a.ph_hi = N_PHASES;
  void* args[] = {&a};
  hipError_t e = hipLaunchCooperativeKernel((const void*)fwd, dim3(grid), dim3(512), args, LDS_BYTES, stream);
  if (e != hipSuccess) fprintf(stderr, "cooperative launch failed: %s (grid %d)\n", hipGetErrorString(e), grid);
#else
  for (int p = 0; p < N_PHASES; ++p) {
    if (p >= 1) { const int l = (p - 1) / 8, k = (p - 1) % 8; if (k == 1 || k == 4 || (k == 7 && l < 3)) continue; }
    a.ph_lo = p; a.ph_hi = p + 1;
    hipLaunchKernelGGL(fwd, dim3(grid), dim3(512), LDS_BYTES, stream, a);
  }
#endif
}
```

```cpp
#include <hip/hip_runtime.h>
#include <hip/hip_cooperative_groups.h>
#include <cstdio>
#include <cstdint>
#include <cmath>
namespace cg = cooperative_groups;
#ifndef MK_N_LAUNCHES
#define MK_N_LAUNCHES 1
#endif
namespace pg8 {
#define PG8_LAS __attribute__((address_space(3)))
typedef unsigned short bf16_t;
typedef short bf16x8 __attribute__((ext_vector_type(8)));
typedef float f32x4 __attribute__((ext_vector_type(4)));
typedef unsigned u32x4 __attribute__((ext_vector_type(4)));
constexpr int BM = 256, BK = 64, HALF = 128, HTB = HALF * BK * 2  , STAGE_BYTES = 8 * HTB, NXCD = 8, WGM = 8;

__host__ __device__ __forceinline__ int lds_byte(int r, int c) { const int st = (r >> 4) * 2 + (c >> 5), rr = r & 15, cc = c & 31, ob = rr * 64 + cc * 2; return st * 1024 + (ob ^ (((ob >> 9) & 1) << 5)); }
__host__ __device__ __forceinline__ void stage_rc(int b, int& R, int& C) { const int st = b / 1024, sb = b % 1024, swz = sb ^ (((sb >> 9) & 1) << 5); R = (st >> 1) * 16 + swz / 64; C = (st & 1) * 32 + (swz % 64) / 2; }
__host__ __device__ __forceinline__ int perm32(int rho) { const int n = rho >> 4, i = rho & 15; return 8 * (i >> 2) + 4 * n + (i & 3); }

struct Unit { int pm, pn, par, sub; };
struct Gemm { const bf16_t* A; const bf16_t* Bt; int M, N, K; };

struct StaticOrder {
    int nM, nN, nwg, G, c, allow_half;
    __host__ __device__ void init(int M, int N, int G_, int c_) { nM = M / BM; nN = N / BM; nwg = nM * nN; G = G_; c = c_; allow_half = 0; }
    __host__ __device__ bool next(int i, Unit& u) const {
        u.sub = -1; long L = (long)i * G + c;
        { const int full = nwg / G, rem = nwg - full * G;
          if (allow_half && rem * 2 == G && i == full) { L = (long)i * G + (c >> 1); u.sub = c & 1; } }
        if (L >= nwg) return false;
        int wgid = (int)L; { const int q = nwg / NXCD, r = nwg % NXCD, xcd = wgid % NXCD, off = wgid / NXCD; wgid = (xcd < r ? xcd * (q + 1) : r * (q + 1) + (xcd - r) * q) + off; }
        const int nig = WGM * nN, gid = wgid / nig, fm = gid * WGM, gsz = (nM - fm) < WGM ? (nM - fm) : WGM;
        u.pm = fm + ((wgid % nig) % gsz); u.pn = (wgid % nig) / gsz; return true;
    }
    __device__ __forceinline__ void a_ready(const Unit&) const {}
    __device__ __forceinline__ void done(const Unit&) const {}
};

__device__ __forceinline__ unsigned cvt_pk_bf16(float lo, float hi) { unsigned r; asm volatile("v_cvt_pk_bf16_f32 %0, %1, %2" : "=v"(r) : "v"(lo), "v"(hi)); return r; }
typedef float f32x2 __attribute__((ext_vector_type(2)));
__device__ __forceinline__ f32x2 gelu_pk(f32x2 v) {
    const f32x2 av = __builtin_elementwise_abs(v), d = av * 0.2316418882f + 1.0f;
    f32x2 t; t.x = __builtin_amdgcn_rcpf(d.x); t.y = __builtin_amdgcn_rcpf(d.y);
    f32x2 q = t * 0.5307027145f + (-0.7265760135f); q = q * t + 0.7107068705f; q = q * t + (-0.142248368f); q = q * t + 0.127414796f; q = q * t;
    const f32x2 s = (v * v) * (-0.72134752044f);
    f32x2 e; e.x = __builtin_amdgcn_exp2f(s.x); e.y = __builtin_amdgcn_exp2f(s.y);
    const f32x2 m = v * (q * e), r = v - m;
    f32x2 o; o.x = v.x < 0.f ? m.x : r.x; o.y = v.y < 0.f ? m.y : r.y; return o;
}

template <int ACT  > struct EpiBf16 {
    static constexpr bool PERM = true, AFTER_DRAIN = false; static_assert(ACT == 0 || ACT == 1, "EpiBf16: ACT is 0 (none) or 1 (gelu_pk)");
    bf16_t* O; int ldc; const float* bias; int split_cols; size_t split_stride; float scale0;
    __device__ __forceinline__ void operator()(const f32x4 (&acc)[2][2][4][2], const Unit& u, int wr, int wc, int fr, int fq) const {
        const int row0 = u.pm * BM + wr * 64 + fr; int colt = u.pn * BM; bf16_t* base = O;
        float sc = 1.f; if (split_cols) { const int t = colt / split_cols; base += (size_t)t * split_stride; colt -= t * split_cols; if (t == 0) sc = scale0; }
        const int col0 = colt + wc * 32 + 8 * fq, bcol0 = u.pn * BM + wc * 32 + 8 * fq;
        f32x4 bv[2][2];
#pragma unroll
        for (int bj = 0; bj < 2; ++bj)
#pragma unroll
            for (int n = 0; n < 2; ++n) bv[bj][n] = bias ? *(const f32x4*)(bias + bcol0 + bj * HALF + 4 * n) : (f32x4){0.f, 0.f, 0.f, 0.f};
#pragma unroll
        for (int ai = 0; ai < 2; ++ai)
#pragma unroll
            for (int m = 0; m < 4; ++m) { bf16_t* rowp = base + (size_t)(row0 + ai * HALF + m * 16) * ldc + col0;
#pragma unroll
                for (int bj = 0; bj < 2; ++bj) { f32x4 v0 = acc[ai][bj][m][0] + bv[bj][0], v1 = acc[ai][bj][m][1] + bv[bj][1];
                    if (ACT == 1) { f32x2 a = gelu_pk((f32x2){v0[0], v0[1]}), b = gelu_pk((f32x2){v0[2], v0[3]}), c = gelu_pk((f32x2){v1[0], v1[1]}), d = gelu_pk((f32x2){v1[2], v1[3]});
                        v0 = (f32x4){a.x, a.y, b.x, b.y}; v1 = (f32x4){c.x, c.y, d.x, d.y}; }
                    v0 = v0 * sc; v1 = v1 * sc; u32x4 w; w.x = cvt_pk_bf16(v0[0], v0[1]); w.y = cvt_pk_bf16(v0[2], v0[3]); w.z = cvt_pk_bf16(v1[0], v1[1]); w.w = cvt_pk_bf16(v1[2], v1[3]);
                    *(u32x4*)(rowp + bj * HALF) = w; } }
    }
};
template <class Epi, class Sched, bool ALIGN_EPI = false, bool SP2 = false>
__device__ __forceinline__ void gemm_phase(PG8_LAS unsigned char* lds, const Gemm g, const Sched& S, const Epi& E) {
    int tid_ = threadIdx.x; asm volatile("" : "+v"(tid_));
    const int tid = tid_, wid = __builtin_amdgcn_readfirstlane(tid >> 6), lane = tid & 63, wr = wid >> 2, wc = wid & 3, fr = lane & 15, fq = lane >> 4;
    const int K = g.K, nt = K / BK;
    unsigned voffA[2], voffB[2];
#pragma unroll
    for (int i = 0; i < 2; ++i) { int R, C; stage_rc(tid * 16 + i * 8192, R, C); const int Rb = Epi::PERM ? ((R & ~31) + perm32(R & 31)) : R;
        voffA[i] = (unsigned)(R * K + C) * 2u; voffB[i] = (unsigned)(Rb * K + C) * 2u; }
    const size_t kstep = (size_t)(BK * 2);
    const size_t hstep = (size_t)HALF * K * 2;
    const size_t tstep = 2 * hstep;
    const unsigned ldsw = (unsigned)wid * 1024u;
    const int aoff = lds_byte(wr * 64 + fr, fq * 8), boff = lds_byte(wc * 32 + fr, fq * 8);
#define PG8_SA(b, h) (((b) * 2 + (h)) * HTB)
#define PG8_SB(b, h) ((4 + (b) * 2 + (h)) * HTB)
#define PG8_STAGE(bufoff, gbase, voff) do { _Pragma("unroll") for (int _i = 0; _i < 2; ++_i) \
        __builtin_amdgcn_global_load_lds((const unsigned*)((const char*)(gbase) + (voff)[_i]), (PG8_LAS unsigned*)(lds + (bufoff) + ldsw + _i * 8192), 16, 0, 0); } while (0)
#define PG8_LDA(dst, b, h) do { _Pragma("unroll") for (int m = 0; m < 4; ++m) _Pragma("unroll") for (int k = 0; k < 2; ++k) dst[m][k] = *(const PG8_LAS bf16x8*)(lds + PG8_SA(b, h) + aoff + m * 2048 + k * 1024); } while (0)
#define PG8_LDB(dst, b, h) do { _Pragma("unroll") for (int n = 0; n < 2; ++n) _Pragma("unroll") for (int k = 0; k < 2; ++k) dst[n][k] = *(const PG8_LAS bf16x8*)(lds + PG8_SB(b, h) + boff + n * 2048 + k * 1024); } while (0)
#define PG8_MMA(ai, bj, At, Bt) do { __builtin_amdgcn_s_setprio(1); _Pragma("unroll") for (int m = 0; m < 4; ++m) _Pragma("unroll") for (int n = 0; n < 2; ++n) _Pragma("unroll") for (int k = 0; k < 2; ++k) \
        acc[ai][bj][m][n] = __builtin_amdgcn_mfma_f32_16x16x32_bf16(Bt[n][k], At[m][k], acc[ai][bj][m][n], 0, 0, 0); __builtin_amdgcn_s_setprio(0); } while (0)
#define PG8_WAIT_V(n) asm volatile("s_waitcnt vmcnt(" #n ")" ::: "memory")
#define PG8_WAIT_L(n) asm volatile("s_waitcnt lgkmcnt(" #n ")" ::: "memory")
#define PG8_BAR __builtin_amdgcn_s_barrier()
#define PG8_SCHED __builtin_amdgcn_sched_barrier(0)
    Unit cur, nxt; int ui = 0;
    if (!S.next(0, cur)) return;
    f32x4 acc[2][2][4][2];
#pragma unroll
    for (int a = 0; a < 2; ++a)
#pragma unroll
        for (int b = 0; b < 2; ++b)
#pragma unroll
            for (int m = 0; m < 4; ++m)
#pragma unroll
                for (int n = 0; n < 2; ++n) acc[a][b][m][n] = (f32x4){0.f, 0.f, 0.f, 0.f};
    bf16x8 At[4][2], B0[2][2], B1[2][2];
    const char* cA = (const char*)g.A + (size_t)cur.pm * tstep + (cur.sub > 0 ? hstep : 0); const char* cB = (const char*)g.Bt + (size_t)cur.pn * tstep;
    bool chalf = cur.sub >= 0; size_t hsc = chalf ? 0 : hstep;
    S.a_ready(cur);
    if constexpr (SP2) {
        PG8_STAGE(PG8_SB(0, 0), cB, voffB); PG8_STAGE(PG8_SB(0, 1), cB + hstep, voffB); PG8_STAGE(PG8_SA(0, 0), cA, voffA); PG8_STAGE(PG8_SA(0, 1), cA + hsc, voffA);
        if (wr == 1) PG8_BAR;
        PG8_WAIT_V(2); PG8_BAR;
        PG8_STAGE(PG8_SB(1, 0), cB + kstep, voffB); PG8_STAGE(PG8_SA(1, 0), cA + kstep, voffA); PG8_STAGE(PG8_SB(1, 1), cB + hstep + kstep, voffB);
        PG8_WAIT_V(6); PG8_BAR;
    } else {
        PG8_STAGE(PG8_SB(0, 0), cB, voffB); PG8_STAGE(PG8_SA(0, 0), cA, voffA); PG8_STAGE(PG8_SB(0, 1), cB + hstep, voffB); PG8_STAGE(PG8_SA(0, 1), cA + hstep, voffA);
        if (wr == 1) PG8_BAR;
        PG8_WAIT_V(4); PG8_BAR;
        PG8_STAGE(PG8_SB(1, 0), cB + kstep, voffB); PG8_STAGE(PG8_SA(1, 0), cA + kstep, voffA); PG8_STAGE(PG8_SB(1, 1), cB + hstep + kstep, voffB);
        PG8_WAIT_V(6); PG8_BAR;
    }
    for (;;) {
        const bool has_next = S.next(ui + 1, nxt);
        const char* nA = has_next ? (const char*)g.A + (size_t)nxt.pm * tstep + (nxt.sub > 0 ? hstep : 0) : cA; const char* nB = has_next ? (const char*)g.Bt + (size_t)nxt.pn * tstep : cB;
        const size_t hsn = has_next ? (nxt.sub >= 0 ? 0 : hstep) : hsc;
        for (int t = 0; t < nt; t += 2) {
            const bool last = (t == nt - 2);
            const char* a1 = cA + (size_t)(t + 1) * kstep;
            const char* a2 = last ? nA : cA + (size_t)(t + 2) * kstep; const char* b2 = last ? nB : cB + (size_t)(t + 2) * kstep;
            const char* a3 = a2 + kstep; const char* b3 = b2 + kstep;
            if (last && has_next) S.a_ready(nxt);
            if constexpr (SP2) {
            PG8_LDB(B0, 0, 0); PG8_LDB(B1, 0, 1); PG8_SCHED; PG8_LDA(At, 0, 0); PG8_STAGE(PG8_SA(1, 1), a1 + hsc, voffA);
            PG8_WAIT_V(8); PG8_WAIT_L(0); PG8_BAR; PG8_MMA(0, 0, At, B0); PG8_MMA(0, 1, At, B1); PG8_BAR; PG8_SCHED;
            if (!chalf) PG8_LDA(At, 0, 1); PG8_STAGE(PG8_SB(0, 0), b2, voffB); PG8_STAGE(PG8_SB(0, 1), b2 + hstep, voffB); PG8_STAGE(PG8_SA(0, 0), a2, voffA);
            PG8_WAIT_V(8); PG8_WAIT_L(0); PG8_BAR; if (!chalf) { PG8_MMA(1, 0, At, B0); PG8_MMA(1, 1, At, B1); } PG8_BAR; PG8_SCHED;
            PG8_LDB(B0, 1, 0); PG8_LDB(B1, 1, 1); PG8_SCHED; PG8_LDA(At, 1, 0); PG8_STAGE(PG8_SA(0, 1), a2 + (last ? hsn : hsc), voffA);
            PG8_WAIT_V(8); PG8_WAIT_L(0); PG8_BAR; PG8_MMA(0, 0, At, B0); PG8_MMA(0, 1, At, B1); PG8_BAR; PG8_SCHED;
            if (!chalf) PG8_LDA(At, 1, 1); PG8_STAGE(PG8_SB(1, 0), b3, voffB); PG8_STAGE(PG8_SB(1, 1), b3 + hstep, voffB); PG8_STAGE(PG8_SA(1, 0), a3, voffA);
            PG8_WAIT_V(8); PG8_WAIT_L(0); PG8_BAR; if (!chalf) { PG8_MMA(1, 0, At, B0); PG8_MMA(1, 1, At, B1); } PG8_BAR; PG8_SCHED;
            } else {
            PG8_LDB(B0, 0, 0); PG8_SCHED; PG8_LDA(At, 0, 0); PG8_STAGE(PG8_SA(1, 1), a1 + hstep, voffA);
            PG8_WAIT_L(8); PG8_BAR; PG8_WAIT_L(0); PG8_MMA(0, 0, At, B0); PG8_BAR; PG8_SCHED;
            PG8_LDB(B1, 0, 1); PG8_STAGE(PG8_SB(0, 0), b2, voffB);
            PG8_BAR; PG8_WAIT_L(0); PG8_MMA(0, 1, At, B1); PG8_BAR;
            PG8_LDA(At, 0, 1); PG8_STAGE(PG8_SA(0, 0), a2, voffA);
            PG8_BAR; PG8_WAIT_L(0); PG8_MMA(1, 0, At, B0); PG8_BAR; PG8_SCHED;
            PG8_STAGE(PG8_SB(0, 1), b2 + hstep, voffB);
            PG8_WAIT_V(6); PG8_BAR; PG8_MMA(1, 1, At, B1); PG8_BAR;
            PG8_LDB(B0, 1, 0); PG8_SCHED; PG8_LDA(At, 1, 0); PG8_STAGE(PG8_SA(0, 1), a2 + hstep, voffA);
            PG8_WAIT_L(8); PG8_BAR; PG8_WAIT_L(0); PG8_MMA(0, 0, At, B0); PG8_BAR; PG8_SCHED;
            PG8_LDB(B1, 1, 1); PG8_STAGE(PG8_SB(1, 0), b3, voffB);
            PG8_BAR; PG8_WAIT_L(0); PG8_MMA(0, 1, At, B1); PG8_BAR;
            PG8_LDA(At, 1, 1); PG8_STAGE(PG8_SA(1, 0), a3, voffA);
            PG8_BAR; PG8_WAIT_L(0); PG8_MMA(1, 0, At, B0); PG8_BAR; PG8_SCHED;
            PG8_STAGE(PG8_SB(1, 1), b3 + hstep, voffB);
            PG8_WAIT_V(6); PG8_BAR; PG8_MMA(1, 1, At, B1); PG8_BAR;
            }
        }
        if constexpr (ALIGN_EPI) { if (wr == 0) PG8_BAR; }
        if constexpr (!Epi::AFTER_DRAIN) { E(acc, cur, wr, wc, fr, fq); S.done(cur); }
        if (!has_next) break;
#pragma unroll
        for (int a = 0; a < 2; ++a)
#pragma unroll
            for (int b = 0; b < 2; ++b)
#pragma unroll
                for (int m = 0; m < 4; ++m)
#pragma unroll
                    for (int n = 0; n < 2; ++n) acc[a][b][m][n] = (f32x4){0.f, 0.f, 0.f, 0.f};
        cur = nxt; cA = nA; cB = nB; ++ui; chalf = cur.sub >= 0; hsc = chalf ? 0 : hstep;
        if constexpr (ALIGN_EPI) { if (wr == 1) PG8_BAR; }
    }
    PG8_WAIT_V(0);
    if constexpr (!ALIGN_EPI) { if (wr == 0) PG8_BAR; }
    PG8_BAR;
    if constexpr (Epi::AFTER_DRAIN) { E.fused(acc, cur, wr, wc, fr, fq, lds, wid, lane); S.done(cur); }
#undef PG8_SA
#undef PG8_SB
#undef PG8_STAGE
#undef PG8_LDA
#undef PG8_LDB
#undef PG8_MMA
#undef PG8_WAIT_V
#undef PG8_WAIT_L
#undef PG8_BAR
#undef PG8_SCHED
}
}

namespace pg8 {
struct RsOrder {
    StaticOrder so; const float* ss; PG8_LAS float* rs;
    static constexpr int MAXU = 8;
    __device__ __forceinline__ bool next(int i, Unit& u) const { const bool ok = so.next(i, u); u.par = i; return ok; }
    __device__ __forceinline__ void build() const {
        if (!ss) return;
        int t_ = threadIdx.x; asm volatile("" : "+v"(t_)); const int t = t_, row = t >> 1, half = t & 1;
#pragma unroll 1
        for (int i0 = 0; i0 < MAXU; i0 += 4) {
            f32x4 acc[4];
#pragma unroll
            for (int i = 0; i < 4; ++i) { Unit u; const bool ok = so.next(i0 + i, u); const int rb = ok ? u.pm * BM + (u.sub > 0 ? HALF : 0) : 0;
                const f32x4* p = (const f32x4*)(ss + (size_t)(rb + row) * 32 + half * 16);
                acc[i] = (p[0] + p[1]) + (p[2] + p[3]); }
#pragma unroll
            for (int i = 0; i < 4; ++i) { float s = (acc[i][0] + acc[i][1]) + (acc[i][2] + acc[i][3]); s += __shfl_xor(s, 1);
                if (!half) rs[(i0 + i) * 256 + row] = rsqrtf(s * (1.0f / 2048.0f) + 1e-6f); }
        }
        __syncthreads();
    }
    __device__ __forceinline__ void a_ready(const Unit&) const {}
    __device__ __forceinline__ void done(const Unit&) const {}
};
struct EpiBf16S {
    static constexpr bool PERM = true, AFTER_DRAIN = false;
    bf16_t* O; int ldc; const PG8_LAS float* rs;
    float* kmp;
    __device__ __forceinline__ void operator()(const f32x4 (&acc)[2][2][4][2], const Unit& u, int wr, int wc, int fr, int fq) const {
        const int row0 = u.pm * BM + (u.sub > 0 ? HALF : 0) + wr * 64 + fr, col0 = u.pn * BM + wc * 32 + 8 * fq;
        const bool dosum = kmp != nullptr && u.pn >= 6 && u.pn < 12;
#pragma unroll
        for (int ai = 0; ai < 2; ++ai) { if (ai == 1 && u.sub >= 0) continue;
            f32x4 cs[2][2] = {{(f32x4){0.f, 0.f, 0.f, 0.f}, (f32x4){0.f, 0.f, 0.f, 0.f}}, {(f32x4){0.f, 0.f, 0.f, 0.f}, (f32x4){0.f, 0.f, 0.f, 0.f}}};
#pragma unroll
            for (int m = 0; m < 4; ++m) { bf16_t* rowp = O + (size_t)(row0 + ai * HALF + m * 16) * ldc + col0;
                const float sc = rs ? rs[u.par * 256 + ai * HALF + wr * 64 + m * 16 + fr] : 1.f;
#pragma unroll
                for (int bj = 0; bj < 2; ++bj) { const f32x4 v0 = acc[ai][bj][m][0] * sc, v1 = acc[ai][bj][m][1] * sc;
                    if (dosum) { cs[bj][0] += v0; cs[bj][1] += v1; }
                    u32x4 w; w.x = cvt_pk_bf16(v0[0], v0[1]); w.y = cvt_pk_bf16(v0[2], v0[3]); w.z = cvt_pk_bf16(v1[0], v1[1]); w.w = cvt_pk_bf16(v1[2], v1[3]);
                    *(u32x4*)(rowp + bj * HALF) = w; } }
            if (dosum) { const int q = (u.sub >= 0 ? u.sub : ai) * 2 + wr; float* kp = kmp + ((size_t)(u.pm * 4 + q) * 1536) + (u.pn - 6) * BM + wc * 32 + 8 * fq;
#pragma unroll
                for (int bj = 0; bj < 2; ++bj)
#pragma unroll
                    for (int n = 0; n < 2; ++n) { f32x4 t = cs[bj][n];
#pragma unroll
                        for (int x = 1; x < 16; x <<= 1) { t[0] += __shfl_xor(t[0], x); t[1] += __shfl_xor(t[1], x); t[2] += __shfl_xor(t[2], x); t[3] += __shfl_xor(t[3], x); }
                        if (fr == 0) *(f32x4*)(kp + bj * HALF + 4 * n) = t; } } }
    }
};
struct EpiResid {
    static constexpr bool PERM = false, AFTER_DRAIN = false;
    const float* basef; const bf16_t* baseh; bf16_t* out; int ldc; float* ss;
    static __device__ __forceinline__ void sw16(unsigned& a, unsigned& b) { auto r = __builtin_amdgcn_permlane16_swap(a, b, false, false); a = r[0]; b = r[1]; }
    __device__ __forceinline__ float put(bf16_t* dst, const f32x4& va, const f32x4& vb) const {
        unsigned w00 = cvt_pk_bf16(va[0], va[1]), w01 = cvt_pk_bf16(va[2], va[3]), w10 = cvt_pk_bf16(vb[0], vb[1]), w11 = cvt_pk_bf16(vb[2], vb[3]);
        const float r0 = __uint_as_float(w00 << 16), r1 = __uint_as_float(w00 & 0xffff0000u), r2 = __uint_as_float(w01 << 16), r3 = __uint_as_float(w01 & 0xffff0000u);
        const float r4 = __uint_as_float(w10 << 16), r5 = __uint_as_float(w10 & 0xffff0000u), r6 = __uint_as_float(w11 << 16), r7 = __uint_as_float(w11 & 0xffff0000u);
        sw16(w00, w10); sw16(w01, w11);
        *(u32x4*)dst = (u32x4){w00, w01, w10, w11};
        return ((r0 * r0 + r1 * r1) + (r2 * r2 + r3 * r3)) + ((r4 * r4 + r5 * r5) + (r6 * r6 + r7 * r7));
    }
    __device__ __forceinline__ void operator()(const f32x4 (&acc)[2][2][4][2], const Unit& u, int wr, int wc, int fr, int fq) const {
        const int col0 = u.pn * BM + wc * 32 + 4 * fq, wcol = u.pn * BM + wc * 32 + (fq & 1) * 16 + (fq >> 1) * 8;
        if (basef) {
#pragma unroll
            for (int ai = 0; ai < 2; ++ai) {
                f32x4 bs[4][2][2];
#pragma unroll
                for (int m = 0; m < 4; ++m) { const size_t off = (size_t)(u.pm * BM + ai * HALF + wr * 64 + m * 16 + fr) * ldc + col0;
#pragma unroll
                    for (int bj = 0; bj < 2; ++bj)
#pragma unroll
                        for (int n = 0; n < 2; ++n) bs[m][bj][n] = *(const f32x4*)(basef + off + bj * HALF + n * 16); }
#pragma unroll
                for (int m = 0; m < 4; ++m) { const int row = u.pm * BM + ai * HALF + wr * 64 + m * 16 + fr; const size_t off = (size_t)row * ldc + wcol; float s = 0.f;
#pragma unroll
                    for (int bj = 0; bj < 2; ++bj) s += put(out + off + bj * HALF, bs[m][bj][0] + acc[ai][bj][m][0], bs[m][bj][1] + acc[ai][bj][m][1]);
                    s += __shfl_xor(s, 16); s += __shfl_xor(s, 32);
                    if (ss && fq == 0) ss[(size_t)row * 32 + u.pn * 4 + wc] = s; }
                asm volatile("" ::: "memory"); }
        } else {
            u32x4 bh[2][4][2];
#pragma unroll
            for (int ai = 0; ai < 2; ++ai)
#pragma unroll
                for (int m = 0; m < 4; ++m) { const size_t off = (size_t)(u.pm * BM + ai * HALF + wr * 64 + m * 16 + fr) * ldc + wcol;
#pragma unroll
                    for (int bj = 0; bj < 2; ++bj) bh[ai][m][bj] = *(const u32x4*)(baseh + off + bj * HALF); }
#pragma unroll
            for (int ai = 0; ai < 2; ++ai)
#pragma unroll
                for (int m = 0; m < 4; ++m) { const int row = u.pm * BM + ai * HALF + wr * 64 + m * 16 + fr; const size_t off = (size_t)row * ldc + wcol; float s = 0.f;
#pragma unroll
                    for (int bj = 0; bj < 2; ++bj) { unsigned ax = bh[ai][m][bj][0], ay = bh[ai][m][bj][1], bx = bh[ai][m][bj][2], by = bh[ai][m][bj][3]; sw16(ax, bx); sw16(ay, by);
                        const f32x4 ba = (f32x4){__uint_as_float(ax << 16), __uint_as_float(ax & 0xffff0000u), __uint_as_float(ay << 16), __uint_as_float(ay & 0xffff0000u)};
                        const f32x4 bb = (f32x4){__uint_as_float(bx << 16), __uint_as_float(bx & 0xffff0000u), __uint_as_float(by << 16), __uint_as_float(by & 0xffff0000u)};
                        s += put(out + off + bj * HALF, ba + acc[ai][bj][m][0], bb + acc[ai][bj][m][1]); }
                    s += __shfl_xor(s, 16); s += __shfl_xor(s, 32);
                    if (ss && fq == 0) ss[(size_t)row * 32 + u.pn * 4 + wc] = s; }
        }
    }
};
struct EpiSwiGLU {
    static constexpr bool PERM = true, AFTER_DRAIN = false;
    bf16_t* O; int ldc; const PG8_LAS float* rs;
    static __device__ __forceinline__ float sw(float g, float u) { return g * __builtin_amdgcn_rcpf(1.0f + __builtin_amdgcn_exp2f(-1.4426950408889634f * g)) * u; }
    __device__ __forceinline__ void operator()(const f32x4 (&acc)[2][2][4][2], const Unit& u, int wr, int wc, int fr, int fq) const {
        const int row0 = u.pm * BM + (u.sub > 0 ? HALF : 0) + wr * 64 + fr, col0 = u.pn * HALF + wc * 32 + 8 * fq;
        float scv[2][4];
#pragma unroll
        for (int ai = 0; ai < 2; ++ai)
#pragma unroll
            for (int m = 0; m < 4; ++m) scv[ai][m] = rs[u.par * 256 + ai * HALF + wr * 64 + m * 16 + fr];
#pragma unroll
        for (int ai = 0; ai < 2; ++ai)
#pragma unroll
            for (int m = 0; m < 4; ++m) { if (ai == 1 && u.sub >= 0) continue; bf16_t* rowp = O + (size_t)(row0 + ai * HALF + m * 16) * ldc + col0;
                const float sc = scv[ai][m];
                const f32x4 g0 = acc[ai][0][m][0] * sc, g1 = acc[ai][0][m][1] * sc, u0 = acc[ai][1][m][0] * sc, u1 = acc[ai][1][m][1] * sc;
                u32x4 w; w.x = cvt_pk_bf16(sw(g0[0], u0[0]), sw(g0[1], u0[1])); w.y = cvt_pk_bf16(sw(g0[2], u0[2]), sw(g0[3], u0[3]));
                w.z = cvt_pk_bf16(sw(g1[0], u1[0]), sw(g1[1], u1[1])); w.w = cvt_pk_bf16(sw(g1[2], u1[2]), sw(g1[3], u1[3]));
                *(u32x4*)rowp = w; asm volatile("" ::: "memory"); }
    }
};
}

namespace att {
typedef unsigned short bf16_t;
using bf16x8 = __attribute__((ext_vector_type(8))) short;
using s16x4  = __attribute__((ext_vector_type(4))) short;
using f32x16 = __attribute__((ext_vector_type(16))) float;
using f32x4  = __attribute__((ext_vector_type(4))) float;
using u32x4  = __attribute__((ext_vector_type(4))) unsigned;
constexpr int NW = 8, QBLK = 32, KVBLK = 64;
constexpr int SHM_V = 16384, SHM_K = 16384;
#ifndef PIPE_OFF_MODE
#define PIPE_OFF_MODE 1
#endif
constexpr int NSLOT = 4, SLOTB = 32768;
constexpr int OFF_WS = NSLOT * SLOTB, OFF_LUT = OFF_WS + 2048, OFF_KM = OFF_LUT + 2560, OFF_MISC = OFF_KM + 3584, ATT_LDS = OFF_MISC + 64;
constexpr float L2E = 1.4426950408889634f;
constexpr float THRL = 8.f;
#define KSWZ(row, colB) ((row) * 256 + ((colB) ^ (((row) & 7) << 4)))
#define SBAR() __builtin_amdgcn_sched_barrier(0)
__device__ __forceinline__ int crow(int r, int hi) { return (r & 3) + 8 * (r >> 2) + 4 * hi; }
__device__ __forceinline__ unsigned cvtpk(float lo, float hi) { unsigned r; asm volatile("v_cvt_pk_bf16_f32 %0, %1, %2" : "=v"(r) : "v"(lo), "v"(hi)); return r; }
__device__ __forceinline__ unsigned short f2bf(float f) { unsigned u = __builtin_bit_cast(unsigned, f); return (unsigned short)((u + 0x7fffu + ((u >> 16) & 1u)) >> 16); }
__device__ __forceinline__ int bucket(int d) {
  return d < 16 ? d : 16 + (d >= 19) + (d >= 21) + (d >= 24) + (d >= 27) + (d >= 31) + (d >= 35) + (d >= 40) + (d >= 46) + (d >= 52) + (d >= 59) + (d >= 67) + (d >= 77) + (d >= 87) + (d >= 99) + (d >= 113);
}
__device__ __forceinline__ void partialSM(f32x16& p0, f32x16& p1, float& m_reg, float& alpha) {
  float pmax = p0[0];
#pragma unroll
  for (int r = 1; r < 16; ++r) pmax = fmaxf(pmax, p0[r]);
#pragma unroll
  for (int r = 0; r < 16; ++r) pmax = fmaxf(pmax, p1[r]);
  { auto rr = __builtin_amdgcn_permlane32_swap(__float_as_uint(pmax), __float_as_uint(pmax), false, false);
    pmax = fmaxf(__uint_as_float(rr[0]), __uint_as_float(rr[1])); }
  float mn;
  if (__builtin_expect(__all(pmax - m_reg <= THRL), 1)) { mn = m_reg; alpha = 1.f; }
  else { mn = fmaxf(m_reg, pmax); alpha = __builtin_amdgcn_exp2f(m_reg - mn); m_reg = mn; }
#pragma unroll
  for (int r = 0; r < 16; ++r) { p0[r] -= mn; p1[r] -= mn; }
#pragma unroll
  for (int r = 0; r < 16; ++r) p0[r] = __builtin_amdgcn_exp2f(p0[r]);
}
__device__ __forceinline__ void finishSM(f32x16& p0, f32x16& p1, float alpha, float& l_reg, bf16x8& pa0, bf16x8& pa1, bf16x8& pa2, bf16x8& pa3) {
#pragma unroll
  for (int r = 0; r < 16; ++r) p1[r] = __builtin_amdgcn_exp2f(p1[r]);
  typedef float f32x2_ __attribute__((ext_vector_type(2)));
  f32x2_ ps2 = {0.f, 0.f};
#pragma unroll
  for (int r = 0; r < 16; r += 2) { ps2 += (f32x2_){p0[r], p0[r + 1]}; ps2 += (f32x2_){p1[r], p1[r + 1]}; }
  float ps = ps2.x + ps2.y;
  { auto rr = __builtin_amdgcn_permlane32_swap(__float_as_uint(ps), __float_as_uint(ps), false, false);
    ps = __uint_as_float(rr[0]) + __uint_as_float(rr[1]); }
  l_reg = l_reg * alpha + ps;
#define PK4(P, BASE, OUT) do { unsigned a0 = cvtpk(P[BASE + 0], P[BASE + 1]), a1 = cvtpk(P[BASE + 2], P[BASE + 3]);   \
    unsigned b0 = cvtpk(P[BASE + 4], P[BASE + 5]), b1 = cvtpk(P[BASE + 6], P[BASE + 7]);                              \
    auto r0 = __builtin_amdgcn_permlane32_swap(a0, b0, false, false); auto r1 = __builtin_amdgcn_permlane32_swap(a1, b1, false, false); \
    u32x4 w = {r0[0], r1[0], r0[1], r1[1]}; OUT = *reinterpret_cast<bf16x8*>(&w); } while (0)
  PK4(p0, 0, pa0); PK4(p0, 8, pa1); PK4(p1, 0, pa2); PK4(p1, 8, pa3);
#undef PK4
}
#define ATT_LAS __attribute__((address_space(3)))
template <int ND> __device__ __forceinline__ void qkt(f32x16& p0, f32x16& p1, const ATT_LAS char* Ks, const bf16x8* qr, int r32, int hi, int dbase) {
  p0 = f32x16{}; p1 = f32x16{};
#pragma unroll
  for (int d0 = 0; d0 < ND; ++d0) { int cb = (dbase + d0 * 16 + hi * 8) * 2;
    bf16x8 b0 = *reinterpret_cast<const ATT_LAS bf16x8*>(Ks + KSWZ(r32, cb));
    bf16x8 b1 = *reinterpret_cast<const ATT_LAS bf16x8*>(Ks + KSWZ(32 + r32, cb));
    p0 = __builtin_amdgcn_mfma_f32_32x32x16_bf16(b0, qr[d0], p0, 0, 0, 0);
    p1 = __builtin_amdgcn_mfma_f32_32x32x16_bf16(b1, qr[d0], p1, 0, 0, 0); }
}
__device__ __forceinline__ int v_st(int k, int c) { const int kk = (k & ~0xC) | ((k & 4) << 1) | ((k & 8) >> 1); return ((kk >> 3) * 4 + (c >> 5)) * 512 + ((kk & 7) * 32 + (c & 31)) * 2; }
__device__ __forceinline__ int v_rd_base(int lane) { return ((lane & 3) << 3) | (((lane >> 2) & 3) << 6) | (((lane >> 4) & 1) << 5) | (((lane >> 5) & 1) << 8); }
constexpr int v_rd_off(int d0, int ks, int half) { return d0 * 512 + ks * 4096 + half * 2048; }
template <int OFF> __device__ __forceinline__ s16x4 tr_read(int vb) {
  s16x4 r; asm volatile("ds_read_b64_tr_b16 %0, %1 offset:%2" : "=&v"(r) : "v"(vb), "i"(OFF) : "memory"); return r;
}
template <int D0> __device__ __forceinline__ void pv_one(f32x16& od, int vb, bf16x8 pa0, bf16x8 pa1, bf16x8 pa2, bf16x8 pa3) {
  const s16x4 l0 = tr_read<v_rd_off(D0, 0, 0)>(vb), h0 = tr_read<v_rd_off(D0, 0, 1)>(vb), l1 = tr_read<v_rd_off(D0, 1, 0)>(vb), h1 = tr_read<v_rd_off(D0, 1, 1)>(vb);
  const s16x4 l2 = tr_read<v_rd_off(D0, 2, 0)>(vb), h2 = tr_read<v_rd_off(D0, 2, 1)>(vb), l3 = tr_read<v_rd_off(D0, 3, 0)>(vb), h3 = tr_read<v_rd_off(D0, 3, 1)>(vb);
  asm volatile("s_waitcnt lgkmcnt(0)" ::: "memory"); SBAR();
#define PK(L, H) (bf16x8){L[0], L[1], L[2], L[3], H[0], H[1], H[2], H[3]}
  od = __builtin_amdgcn_mfma_f32_32x32x16_bf16(pa0, PK(l0, h0), od, 0, 0, 0);
  od = __builtin_amdgcn_mfma_f32_32x32x16_bf16(pa1, PK(l1, h1), od, 0, 0, 0);
  od = __builtin_amdgcn_mfma_f32_32x32x16_bf16(pa2, PK(l2, h2), od, 0, 0, 0);
  od = __builtin_amdgcn_mfma_f32_32x32x16_bf16(pa3, PK(l3, h3), od, 0, 0, 0);
#undef PK
}
__device__ __forceinline__ void pv_d0(f32x16* o, int vb, bf16x8 pa0, bf16x8 pa1, bf16x8 pa2, bf16x8 pa3) {
  pv_one<0>(o[0], vb, pa0, pa1, pa2, pa3); pv_one<1>(o[1], vb, pa0, pa1, pa2, pa3); pv_one<2>(o[2], vb, pa0, pa1, pa2, pa3); pv_one<3>(o[3], vb, pa0, pa1, pa2, pa3);
}

__device__ __forceinline__ float sum32(float v) {
#define ATT_ROR(N) v += __uint_as_float((unsigned)__builtin_amdgcn_update_dpp(0, (int)__float_as_uint(v), 0x120 + (N), 0xf, 0xf, false))
  ATT_ROR(8); ATT_ROR(4); ATT_ROR(2); ATT_ROR(1);
#undef ATT_ROR
  auto a = __builtin_amdgcn_permlane16_swap(__float_as_uint(v), __float_as_uint(v), false, false);
  return __uint_as_float(a[0]) + __uint_as_float(a[1]);
}
struct UnitP {
  const bf16_t* Q; int ldq;
  const bf16_t* K; const bf16_t* V; int ldk;
  bf16_t* Y; int ldy;
  int NT, qpos0, qb;
  const float* bias_col;
  const float* km;
  const float* lamp; const float* gsub;
  unsigned* ticket;
};

constexpr int LUT_D0 = 207, LUT_N = 304;
template <int MODE>
__device__ __forceinline__ void score_sm(f32x16& p0, f32x16& p1, int kv0, int qpos, int qwmin, int hi, const ATT_LAS float* lutR, unsigned selmask, int qb, float& m_reg, float& alpha) {
  constexpr float C = ((MODE == 2) ? 0.125f : 0.08838834764831845f) * L2E;
  bool rowsel = true;
  if (MODE == 1) { const int n = kv0 >> 8; rowsel = (n >= qb) || ((selmask >> n) & 1u); }
  const bool above = (MODE != 0) && (kv0 > qwmin + 31);
  const bool farp = (MODE == 0) || above || (qwmin - (kv0 + 63) >= 113);
  if (farp) {
    float add = 0.f;
    if (MODE != 0) add = (rowsel && !above) ? lutR[LUT_D0 - 127] : -INFINITY;
    float pmax = p0[0];
#pragma unroll
    for (int r = 1; r < 16; ++r) pmax = fmaxf(pmax, p0[r]);
#pragma unroll
    for (int r = 0; r < 16; ++r) pmax = fmaxf(pmax, p1[r]);
    { auto rr = __builtin_amdgcn_permlane32_swap(__float_as_uint(pmax), __float_as_uint(pmax), false, false);
      pmax = fmaxf(__uint_as_float(rr[0]), __uint_as_float(rr[1])); }
    const float pm = fmaf(pmax, C, add);
    float mn;
    if (__builtin_expect(__all(pm - m_reg <= THRL), 1)) { mn = m_reg; alpha = 1.f; }
    else { mn = fmaxf(m_reg, pm); alpha = __builtin_amdgcn_exp2f(m_reg - mn); m_reg = mn; }
    const float off = add - mn;
    p0 = p0 * C + off; p1 = p1 * C + off;
#pragma unroll
    for (int r = 0; r < 16; ++r) p0[r] = __builtin_amdgcn_exp2f(p0[r]);
  } else {
    const ATT_LAS float* tb = lutR + (rowsel ? 0 : LUT_N) + (LUT_D0 - (qpos - kv0) + 4 * hi);
#pragma unroll
    for (int r = 0; r < 16; ++r) { const int c = (r & 3) + 8 * (r >> 2); p0[r] = fmaf(p0[r], C, tb[c]); p1[r] = fmaf(p1[r], C, tb[c + 32]); }
    partialSM(p0, p1, m_reg, alpha);
  }
}

template <int MODE>
__device__ __forceinline__ void attn_unit(ATT_LAS unsigned char* L, const UnitP& P) {
  int tid_ = threadIdx.x; asm volatile("" : "+v"(tid_));
  const int tid = tid_, wid = __builtin_amdgcn_readfirstlane(tid >> 6), lane = tid & 63, r32 = lane & 31, hi = lane >> 5;
  const int wq = (MODE == 2) ? (wid & 3) : wid, dsel = (MODE == 2) ? (wid >> 2) : 0;
  constexpr int ND = (MODE == 2) ? 4 : 8;
  const int dbase = dsel * 64;
  ATT_LAS float* ws = (ATT_LAS float*)(L + OFF_WS) + wid * 64; ATT_LAS float* li_l = ws; ATT_LAS float* al_l = ws + 32;
  ATT_LAS float* lut = (ATT_LAS float*)(L + OFF_LUT); ATT_LAS float* kml = (ATT_LAS float*)(L + OFF_KM);
  const bf16_t* Kh = P.K; const bf16_t* Vh = P.V; const int LDK = P.ldk; const int NT = P.NT;
  int ksrc[2], vsrc[2];
#pragma unroll
  for (int i = 0; i < 2; ++i) { const int p = (wid * 2 + i) * 1024 + lane * 16;
    const int row = p >> 8, colB = (p & 255) ^ ((row & 7) << 4); ksrc[i] = row * LDK + (colB >> 1);
    const int sub = p >> 9, w = p & 511, kk = (sub >> 2) * 8 + (w >> 6), k = (kk & ~0xC) | ((kk & 4) << 1) | ((kk & 8) >> 1), c = (sub & 3) * 32 + ((w & 63) >> 1); vsrc[i] = k * LDK + c; }
#define DMA(t, sl) do { const bf16_t* kb_ = Kh + (long)(t) * KVBLK * LDK; const bf16_t* vb_ = Vh + (long)(t) * KVBLK * LDK; \
    _Pragma("unroll") for (int i_ = 0; i_ < 2; ++i_) __builtin_amdgcn_global_load_lds((const unsigned*)(kb_ + ksrc[i_]), (ATT_LAS unsigned*)(L + (sl) + (wid * 2 + i_) * 1024), 16, 0, 0); \
    _Pragma("unroll") for (int i_ = 0; i_ < 2; ++i_) __builtin_amdgcn_global_load_lds((const unsigned*)(vb_ + vsrc[i_]), (ATT_LAS unsigned*)(L + (sl) + 16384 + (wid * 2 + i_) * 1024), 16, 0, 0); } while (0)
  DMA(0, 0); DMA(1, SLOTB); if (2 < NT) DMA(2, 2 * SLOTB);
  const float bfar = 0.f;
  if (MODE != 0) { if (tid < LUT_N) { const int d = LUT_D0 - tid; lut[tid] = d < 0 ? -INFINITY : P.bias_col[bucket(min(d, 127)) * 12] * L2E; lut[LUT_N + tid] = -INFINITY; } }
  if (MODE == 1) { if (P.qb >= 4) for (int i = tid; i < P.qb * 128; i += 512) { const float* kp = P.km + (size_t)((i >> 7) * 4) * 1536 + (i & 127); kml[i] = ((kp[0] + kp[1536]) + (kp[2 * 1536] + kp[3 * 1536])) * (1.0f / 256.0f); } }
  float m_reg = -1e30f, l_reg = 0; f32x16 o[4] = {}; bf16x8 qr[ND];
  const bf16_t* Qw = P.Q + (long)(wq * QBLK + r32) * P.ldq + dbase + hi * 8;
#pragma unroll
  for (int d0 = 0; d0 < ND; ++d0) qr[d0] = *reinterpret_cast<const bf16x8*>(Qw + d0 * 16);
  const int qwmin = P.qpos0 + wq * 32, qpos = qwmin + r32, qb = P.qb;
  constexpr float C = ((MODE == 2) ? 0.125f : 0.08838834764831845f) * L2E;
  const int vb0 = (int)(size_t)(L + 16384) + v_rd_base(lane);
#define RESC(a) do { if (__any((a) < 1.f)) { if (hi == 0) al_l[r32] = (a); asm volatile("s_waitcnt lgkmcnt(0)" ::: "memory"); \
    _Pragma("unroll") for (int d = 0; d < 4; ++d) _Pragma("unroll") for (int r = 0; r < 16; ++r) o[d][r] *= al_l[crow(r, hi)]; } } while (0)
#define XFSM(PX0, PX1, j, AL) score_sm<MODE>(PX0, PX1, (j) * KVBLK, qpos, qwmin, hi, lut, selmask, qb, m_reg, AL)
  f32x16 p0, p1; float al; bf16x8 pa0, pa1, pa2, pa3;
  asm volatile("s_waitcnt vmcnt(0) lgkmcnt(0)\n\ts_barrier" ::: "memory");
  unsigned selmask = 0xFFu;
  if (MODE == 1) { if (qb >= 4) {
    float g[7];
#pragma unroll
    for (int n = 0; n < 7; ++n) { float s = 0.f;
      if (n < qb) {
#pragma unroll
        for (int d0 = 0; d0 < ND; ++d0) { const f32x4 k0 = *(const ATT_LAS f32x4*)&kml[n * 128 + d0 * 16 + hi * 8], k1 = *(const ATT_LAS f32x4*)&kml[n * 128 + d0 * 16 + hi * 8 + 4];
#pragma unroll
          for (int i = 0; i < 4; ++i) { s = fmaf(__uint_as_float(((unsigned)(unsigned short)qr[d0][i]) << 16), k0[i], s); s = fmaf(__uint_as_float(((unsigned)(unsigned short)qr[d0][4 + i]) << 16), k1[i], s); } } }
      { auto rr = __builtin_amdgcn_permlane32_swap(__float_as_uint(s), __float_as_uint(s), false, false); s = __uint_as_float(rr[0]) + __uint_as_float(rr[1]); }
      g[n] = s; }
    selmask = 0u;
#pragma unroll
    for (int n = 0; n < 7; ++n) { int cnt = 0;
#pragma unroll
      for (int m = 0; m < 7; ++m) if (m != n) cnt += (m < qb && (g[m] > g[n] || (g[m] == g[n] && m < n))) ? 1 : 0;
      if (n < qb && cnt < 3) selmask |= (1u << n); }
  } }
  if constexpr (MODE == PIPE_OFF_MODE) {
  int s_cur = 0, s_pre = 3 * SLOTB;
#pragma unroll 1
  for (int j = 0; j < NT; ++j) {
    const bool more2 = j + 3 < NT;
    if (more2) DMA(j + 3, s_pre);
    SBAR(); qkt<ND>(p0, p1, (const ATT_LAS char*)(L + s_cur), qr, r32, hi, dbase);
    XFSM(p0, p1, j, al);
    if (j > 0) RESC(al);
    finishSM(p0, p1, al, l_reg, pa0, pa1, pa2, pa3); SBAR();
    pv_d0(o, vb0 + s_cur, pa0, pa1, pa2, pa3);
    if (j + 1 < NT) {
      if (more2) asm volatile("s_waitcnt vmcnt(4) lgkmcnt(0)\n\ts_barrier" ::: "memory");
      else asm volatile("s_waitcnt vmcnt(0) lgkmcnt(0)\n\ts_barrier" ::: "memory");
    }
    s_cur = (s_cur == (NSLOT - 1) * SLOTB) ? 0 : s_cur + SLOTB; s_pre = (s_pre == (NSLOT - 1) * SLOTB) ? 0 : s_pre + SLOTB;
  }
  } else {
  f32x16 pB0, pB1; float alB;
#define SLOT(t) (((t) & 3) * SLOTB)
#define STEP_END(j) do { if ((j) + 1 < NT) { if ((j) + 2 < NT) asm volatile("s_waitcnt vmcnt(4) lgkmcnt(0)\n\ts_barrier" ::: "memory"); else asm volatile("s_waitcnt vmcnt(0) lgkmcnt(0)\n\ts_barrier" ::: "memory"); } } while (0)
  qkt<ND>(p0, p1, (const ATT_LAS char*)(L + SLOT(0)), qr, r32, hi, dbase); XFSM(p0, p1, 0, al);
#pragma unroll 1
  for (int j = 1; j < NT; j += 2) {
    if (j + 2 < NT) DMA(j + 2, SLOT(j + 2));
    SBAR(); qkt<ND>(pB0, pB1, (const ATT_LAS char*)(L + SLOT(j)), qr, r32, hi, dbase);
    finishSM(p0, p1, al, l_reg, pa0, pa1, pa2, pa3); SBAR();
    pv_d0(o, vb0 + SLOT(j - 1), pa0, pa1, pa2, pa3); XFSM(pB0, pB1, j, alB);
    RESC(alB);
    STEP_END(j);
    if (j + 1 < NT) {
      if (j + 3 < NT) DMA(j + 3, SLOT(j + 3));
      SBAR(); qkt<ND>(p0, p1, (const ATT_LAS char*)(L + SLOT(j + 1)), qr, r32, hi, dbase);
      finishSM(pB0, pB1, alB, l_reg, pa0, pa1, pa2, pa3); SBAR();
      pv_d0(o, vb0 + SLOT(j), pa0, pa1, pa2, pa3); XFSM(p0, p1, j + 1, al);
      RESC(al);
      STEP_END(j + 1);
    }
  }
  finishSM(pB0, pB1, alB, l_reg, pa0, pa1, pa2, pa3); SBAR();
  pv_d0(o, vb0 + SLOT(NT - 1), pa0, pa1, pa2, pa3);
#undef SLOT
#undef STEP_END
  }
  unsigned nticket = 0u; if (tid == 0) nticket = atomicAdd(P.ticket, 1u);
  if (hi == 0) li_l[r32] = l_reg; asm volatile("s_waitcnt lgkmcnt(0)" ::: "memory");
  float rli[16];
#pragma unroll
  for (int r = 0; r < 16; ++r) rli[r] = __builtin_amdgcn_rcpf(li_l[crow(r, hi)]);
  bf16_t* Yw = P.Y + (long)(wq * QBLK) * P.ldy;
  if (MODE != 2) {
#pragma unroll
    for (int r = 0; r < 16; r += 2) { const int orow = crow(r, hi);
#pragma unroll
      for (int d0 = 0; d0 < 4; ++d0) { const unsigned w = cvtpk(o[d0][r] * rli[r], o[d0][r + 1] * rli[r + 1]);
        Yw[(long)orow * P.ldy + d0 * 32 + r32] = (unsigned short)(w & 0xffffu); Yw[(long)(orow + 1) * P.ldy + d0 * 32 + r32] = (unsigned short)(w >> 16); } }
    if (tid == 0) *(volatile ATT_LAS unsigned*)(L + OFF_MISC) = nticket;
    __syncthreads();
  } else {
    ATT_LAS f32x4* exch = (ATT_LAS f32x4*)(L + (wid & 3) * 17408) + lane * 17;
    __syncthreads();
    if (dsel == 1) { const float lam = P.lamp[0];
#pragma unroll
      for (int r = 0; r < 16; ++r) { const float f = rli[r] * lam; exch[r] = (f32x4){o[0][r] * f, o[1][r] * f, o[2][r] * f, o[3][r] * f}; }
    }
    __syncthreads();
    if (dsel == 0) {
      float gs[4];
#pragma unroll
      for (int d0 = 0; d0 < 4; ++d0) gs[d0] = P.gsub[d0 * 32 + r32];
      f32x4 ex[16];
#pragma unroll
      for (int r = 0; r < 16; ++r) ex[r] = exch[r];
      const float osc = P.lamp[2];
#pragma unroll
      for (int r = 0; r < 16; r += 2) {
        float v0[4], v1[4], s0 = 0.f, s1 = 0.f;
#pragma unroll
        for (int d0 = 0; d0 < 4; ++d0) { v0[d0] = o[d0][r] * rli[r] - ex[r][d0]; s0 = fmaf(v0[d0], v0[d0], s0); v1[d0] = o[d0][r + 1] * rli[r + 1] - ex[r + 1][d0]; s1 = fmaf(v1[d0], v1[d0], s1); }
        s0 = rsqrtf(sum32(s0) * (1.0f / 128.0f) + 1e-6f) * osc; s1 = rsqrtf(sum32(s1) * (1.0f / 128.0f) + 1e-6f) * osc;
        const int orow = crow(r, hi);
#pragma unroll
        for (int d0 = 0; d0 < 4; ++d0) { const unsigned w = cvtpk(v0[d0] * s0 * gs[d0], v1[d0] * s1 * gs[d0]);
          Yw[(long)orow * P.ldy + d0 * 32 + r32] = (unsigned short)(w & 0xffffu); Yw[(long)(orow + 1) * P.ldy + d0 * 32 + r32] = (unsigned short)(w >> 16); } }
    }
    if (tid == 0) *(volatile ATT_LAS unsigned*)(L + OFF_MISC) = nticket;
    __syncthreads();
  }
#undef DMA
#undef RESC
#undef XFSM
}
}

constexpr int DM = 2048, NB = 4, SEQ = 2048, NTOK = NB * SEQ, DEPTH = 4, HD = 128, NSH = 12, NMH = 4, SW = 1536, MW = 512, NMEM = 256, NMTOK = NB * NMEM;
constexpr int DFF = 5632, NINA = 3 * SW + MW  , NINB = SW + MW  , NKV = 2 * SW  , NGU = 2 * DFF  , NMKV = 2 * MW  ;
constexpr float RMS_EPS = 1e-6f;
constexpr size_t MiB = 1u << 20;
constexpr size_t WS_CTL = 0, WS_WINA = 1 * MiB, WS_WINB = 41 * MiB, WS_WMEM = 57 * MiB, WS_WO = 73 * MiB, WS_WGU = 105 * MiB, WS_WDN = 281 * MiB, WS_WKV = 369 * MiB;
constexpr size_t WS_H = 381 * MiB, WS_XN = 445 * MiB, WS_XKV = 477 * MiB, WS_MN = 509 * MiB, WS_MKV = 525 * MiB, WS_PROJ = 533 * MiB, WS_KVS = 613 * MiB, WS_Y = 661 * MiB, WS_ACT = 693 * MiB, WS_KM = 781 * MiB, WS_H2 = 782 * MiB, WS_SS = 846 * MiB, WS_END = 848 * MiB;
static_assert(WS_WINB - WS_WINA >= (size_t)2 * NINA * DM * 2 && WS_WGU - WS_WO >= (size_t)4 * DM * DM * 2 && WS_WDN - WS_WGU >= (size_t)4 * NGU * DM * 2 && WS_WKV - WS_WDN >= (size_t)4 * DM * DFF * 2 && WS_H - WS_WKV >= (size_t)NKV * DM * 2, "ws map (weights)");
static_assert(WS_XN - WS_H >= (size_t)NTOK * DM * 4 && WS_KVS - WS_PROJ >= (size_t)NTOK * NINA * 2 && WS_Y - WS_KVS >= (size_t)NTOK * NKV * 2 && WS_KM - WS_ACT >= (size_t)NTOK * DFF * 2, "ws map (activations)");
constexpr int LDS_BYTES = 143360;

#define LAS __attribute__((address_space(3)))
typedef unsigned short bf16_t;
typedef float f32x4 __attribute__((ext_vector_type(4)));
typedef unsigned v4u __attribute__((ext_vector_type(4)));
__device__ __forceinline__ unsigned f2bf_u(float f) { unsigned u = __builtin_bit_cast(unsigned, f); return (u + 0x7fffu + ((u >> 16) & 1u)) >> 16; }
__device__ __forceinline__ unsigned pk2(float lo, float hi) { return f2bf_u(lo) | (f2bf_u(hi) << 16); }
__device__ __forceinline__ float wave_sum(float v) {
#pragma unroll
  for (int o = 1; o < 64; o <<= 1) v += __shfl_xor(v, o);
  return v;
}
#define XB_TMO      128
#define XB_XCNT(j)  (256  + 64 * (j))
#define XB_XSUB(j)  (1280 + 64 * (j))
#define XB_XGEN(j)  (2304 + 64 * (j))
#define XB_TOP      3328
#define XB_TOPGEN   3392
#define XCD_BAR_WORDS 3456
#define XB_SPIN_CAP (1u << 18)

__device__ __forceinline__ unsigned xb_ld(unsigned* p)              { return __hip_atomic_load(p, __ATOMIC_RELAXED, __HIP_MEMORY_SCOPE_AGENT); }
__device__ __forceinline__ unsigned xb_add(unsigned* p, unsigned v) { return __hip_atomic_fetch_add(p, v, __ATOMIC_RELAXED, __HIP_MEMORY_SCOPE_AGENT); }
__device__ __forceinline__ unsigned xb_xcc_id() { return (unsigned)__builtin_amdgcn_s_getreg((3 << 11) | 20) & 0xFu; }
#define XB_SPIN(cond, bar) do { unsigned _sp = 0; while (cond) { __builtin_amdgcn_s_sleep(1); \
    if ((++_sp & 255u) == 0u) { if (xb_ld(&(bar)[XB_TMO])) break; if (_sp > XB_SPIN_CAP) { atomicAdd(&(bar)[XB_TMO], 1u); break; } } } } while (0)

struct XcdBarrier {
    unsigned* bar; unsigned x;
    volatile LAS unsigned* st;
};

__device__ __forceinline__ XcdBarrier xcd_barrier_post(unsigned* bar, volatile LAS unsigned* st) {
    XcdBarrier b; b.bar = bar; b.x = xb_xcc_id(); b.st = st;
    if (threadIdx.x == 0) (void)xb_add(&bar[XB_XCNT(b.x)], 1u);
    return b;
}
__device__ __forceinline__ void xcd_barrier_complete(unsigned* bar, unsigned x, unsigned& nloc, unsigned& nx) {
    const unsigned G = gridDim.x * gridDim.y * gridDim.z;
    unsigned sum, cnt, mine, sp = 0u;
    for (;;) {
        sum = 0u; cnt = 0u; mine = 0u;
#pragma unroll
        for (unsigned j = 0; j < 16; ++j) { const unsigned c = xb_ld(&bar[XB_XCNT(j)]); sum += c; cnt += (c > 0u) ? 1u : 0u; mine = (j == x) ? c : mine; }
        if (sum == G) break;
        __builtin_amdgcn_s_sleep(1);
        if ((++sp & 255u) == 0u) { if (xb_ld(&bar[XB_TMO])) break; if (sp > XB_SPIN_CAP) { atomicAdd(&bar[XB_TMO], 1u); break; } }
    }
    nloc = mine > 0u ? mine : 1u; nx = cnt > 0u ? cnt : 1u;
}

__device__ __forceinline__ void xcd_barrier(const XcdBarrier& b) {
    asm volatile("s_waitcnt vmcnt(0)" ::: "memory");
    __syncthreads();
    if (threadIdx.x == 0) {
        unsigned* bar = b.bar;
        __builtin_amdgcn_s_waitcnt(0);
        unsigned nloc = b.st[0], nx = b.st[1];
        if (nloc == 0u) { xcd_barrier_complete(bar, b.x, nloc, nx); b.st[0] = nloc; b.st[1] = nx; }
        const unsigned old = xb_add(&bar[XB_XSUB(b.x)], 1u);
        const unsigned gen = old / nloc;
        if (old + 1u == (gen + 1u) * nloc) {
            __builtin_amdgcn_fence(__ATOMIC_RELEASE, "agent");
            asm volatile("s_waitcnt vmcnt(0)" ::: "memory");
            const unsigned og = xb_add(&bar[XB_TOP], 1u);
            const unsigned tg = og / nx;
            if (og + 1u == (tg + 1u) * nx) xb_add(&bar[XB_TOPGEN], 1u);
            else XB_SPIN(xb_ld(&bar[XB_TOPGEN]) == tg, bar);
            __builtin_amdgcn_fence(__ATOMIC_ACQUIRE, "agent");
            xb_add(&bar[XB_XGEN(b.x)], 1u);
            asm volatile("s_waitcnt vmcnt(0)" ::: "memory");
        } else {
            XB_SPIN(xb_ld(&bar[XB_XGEN(b.x)]) == gen, bar);
            __builtin_amdgcn_fence(__ATOMIC_ACQUIRE, "agent");
            asm volatile("s_waitcnt vmcnt(0)" ::: "memory");
        }
    }
    __syncthreads();
}

__device__ __forceinline__ void transpose_item(const float* W, int K, int N, bf16_t* WT, bool gu, LAS float* scr, int item, int lane, const float* gk = nullptr) {
  const int nblk = N / 64, kb = item / nblk, nb = item % nblk, k0 = 64 * kb, n0 = 64 * nb;
  int nr0 = n0;
  if (gu) { const int half = n0 >= DFF, np = n0 - half * DFF; nr0 = (np >> 7) * 256 + half * 128 + (np & 127); }
#pragma unroll 16
  for (int i = 0; i < 64; ++i) scr[i * 65 + lane] = __builtin_nontemporal_load(&W[(size_t)(k0 + i) * N + n0 + lane]);
  asm volatile("s_waitcnt lgkmcnt(0)" ::: "memory");
  const int c = lane & 7;
  f32x4 ga = {1.f, 1.f, 1.f, 1.f}, gb = {1.f, 1.f, 1.f, 1.f};
  if (gk) { ga = *(const f32x4*)(gk + k0 + 8 * c); gb = *(const f32x4*)(gk + k0 + 8 * c + 4); }
#pragma unroll
  for (int j = 0; j < 8; ++j) { const int n = (lane >> 3) + 8 * j; const LAS float* s = scr + (8 * c) * 65 + n;
    v4u o; o.x = pg8::cvt_pk_bf16(s[0 * 65] * ga[0], s[1 * 65] * ga[1]); o.y = pg8::cvt_pk_bf16(s[2 * 65] * ga[2], s[3 * 65] * ga[3]); o.z = pg8::cvt_pk_bf16(s[4 * 65] * gb[0], s[5 * 65] * gb[1]); o.w = pg8::cvt_pk_bf16(s[6 * 65] * gb[2], s[7 * 65] * gb[3]);
    __builtin_nontemporal_store(o, (v4u*)(WT + (size_t)(nr0 + n) * K + k0 + 8 * c)); }
  asm volatile("s_waitcnt lgkmcnt(0)" ::: "memory");
}
__device__ __forceinline__ void rms_row(const float* xrow, int lane, const float* g0, bf16_t* o0, const float* g1, bf16_t* o1, float* fo) {
  const f32x4* xr = (const f32x4*)xrow + lane;
  f32x4 v[8]; float s = 0.f;
#pragma unroll
  for (int j = 0; j < 8; ++j) { v[j] = xr[64 * j]; s += (v[j].x * v[j].x + v[j].y * v[j].y) + (v[j].z * v[j].z + v[j].w * v[j].w); }
  const float r = rsqrtf(wave_sum(s) * (1.0f / DM) + RMS_EPS);
#pragma unroll
  for (int j = 0; j < 8; ++j) {
    const f32x4 gv = ((const f32x4*)g0)[lane + 64 * j]; const f32x4 y = v[j] * r * gv;
    if (fo) ((f32x4*)fo)[lane + 64 * j] = y;
    else ((unsigned long long*)o0)[lane + 64 * j] = (unsigned long long)pk2(y.x, y.y) | ((unsigned long long)pk2(y.z, y.w) << 32);
    if (g1) { const f32x4 g2 = ((const f32x4*)g1)[lane + 64 * j]; const f32x4 y2 = v[j] * r * g2;
      ((unsigned long long*)o1)[lane + 64 * j] = (unsigned long long)pk2(y2.x, y2.y) | ((unsigned long long)pk2(y2.z, y2.w) << 32); }
  }
}

template <int R>
__device__ __forceinline__ void rms_rows(const float* X, int m0, int mstride, int mend, int lane, const float* g0, bf16_t* o0, float* fo) {
  f32x4 v[R][8];
#pragma unroll
  for (int i = 0; i < R; ++i) { const int m = m0 + i * mstride; if (m < mend) { const f32x4* xr = (const f32x4*)(X + (size_t)m * DM) + lane;
#pragma unroll
      for (int j = 0; j < 8; ++j) v[i][j] = xr[64 * j]; } }
#pragma unroll
  for (int i = 0; i < R; ++i) { const int m = m0 + i * mstride; if (m < mend) { float s = 0.f;
#pragma unroll
      for (int j = 0; j < 8; ++j) s += (v[i][j].x * v[i][j].x + v[i][j].y * v[i][j].y) + (v[i][j].z * v[i][j].z + v[i][j].w * v[i][j].w);
      const float r = rsqrtf(wave_sum(s) * (1.0f / DM) + RMS_EPS);
#pragma unroll
      for (int j = 0; j < 8; ++j) { const f32x4 gv = g0 ? ((const f32x4*)g0)[lane + 64 * j] : (f32x4){1.f, 1.f, 1.f, 1.f}; const f32x4 y = v[i][j] * r * gv;
        if (fo) ((f32x4*)(fo + (size_t)m * DM))[lane + 64 * j] = y;
        else ((unsigned long long*)(o0 + (size_t)m * DM))[lane + 64 * j] = (unsigned long long)pk2(y.x, y.y) | ((unsigned long long)pk2(y.z, y.w) << 32); } } }
}
template <int R>
__device__ __forceinline__ void rms_rows_h(const bf16_t* X, int m0, int mstride, int mend, int lane, const float* g0, float* fo) {
  v4u v[R][4];
#pragma unroll
  for (int i = 0; i < R; ++i) { const int m = m0 + i * mstride; if (m < mend) { const v4u* xr = (const v4u*)(X + (size_t)m * DM) + lane;
#pragma unroll
      for (int j = 0; j < 4; ++j) v[i][j] = xr[64 * j]; } }
#pragma unroll
  for (int i = 0; i < R; ++i) { const int m = m0 + i * mstride; if (m < mend) { float s = 0.f;
#pragma unroll
      for (int j = 0; j < 4; ++j)
#pragma unroll
        for (int e = 0; e < 4; ++e) { const float a = __uint_as_float(v[i][j][e] << 16), b = __uint_as_float(v[i][j][e] & 0xffff0000u); s += a * a + b * b; }
      const float r = rsqrtf(wave_sum(s) * (1.0f / DM) + RMS_EPS);
#pragma unroll
      for (int j = 0; j < 4; ++j) { const int c0 = (lane + 64 * j) * 8; const f32x4 ga = *(const f32x4*)(g0 + c0), gb = *(const f32x4*)(g0 + c0 + 4);
        const f32x4 ya = (f32x4){__uint_as_float(v[i][j][0] << 16), __uint_as_float(v[i][j][0] & 0xffff0000u), __uint_as_float(v[i][j][1] << 16), __uint_as_float(v[i][j][1] & 0xffff0000u)} * r * ga;
        const f32x4 yb = (f32x4){__uint_as_float(v[i][j][2] << 16), __uint_as_float(v[i][j][2] & 0xffff0000u), __uint_as_float(v[i][j][3] << 16), __uint_as_float(v[i][j][3] & 0xffff0000u)} * r * gb;
        *(f32x4*)(fo + (size_t)m * DM + c0) = ya; *(f32x4*)(fo + (size_t)m * DM + c0 + 4) = yb; } } }
}
struct Args { const float* in[17]; float* out; unsigned char* ws; int ph_lo, ph_hi; };
constexpr int N_PHASES = 1 + 8 * DEPTH;

__global__ void __launch_bounds__(512, 2) fwd(Args a) {
  extern __shared__ __attribute__((aligned(16))) unsigned char lds[];
  cg::grid_group grid = cg::this_grid();
  const int wave = __builtin_amdgcn_readfirstlane((int)threadIdx.x >> 6), G = gridDim.x, bid = blockIdx.x;
  const int gw = bid * 8 + wave, NGW = G * 8;
  const int lo = a.ph_lo, hiP = a.ph_hi;
#ifndef REP_CLASS
#define REP_CLASS -1
#endif
#define REPS(k) ((REP_CLASS == (k)) ? 2 : 1)
#define RUN(k) (lo <= (k) && (k) < hiP)
#define GSYNC() xcd_barrier(xbar)
#define SEAM(k) do { if (RUN(k) && RUN((k) + 1)) GSYNC(); } while (0)
#define PHASE_BEGIN const __attribute__((address_space(4))) Args* ka = (const __attribute__((address_space(4))) Args*)__builtin_amdgcn_kernarg_segment_ptr(); asm volatile("" : "+s"(ka)); unsigned char* ws = ka->ws; int tid = threadIdx.x; asm volatile("" : "+v"(tid)); const int lane = tid & 63; (void)lane; (void)ws; \
  unsigned* ctl = (unsigned*)(ws + WS_CTL); (void)ctl;
#define X_IN (ka->in[0])
#define MEM_IN (ka->in[1])
#define rel_bias (ka->in[2])
#define g_mix (ka->in[3])
#define w_in_a (ka->in[4])
#define w_in_b (ka->in[5])
#define g_mem (ka->in[6])
#define w_mem_kv (ka->in[7])
#define w_o (ka->in[8])
#define g_ffn (ka->in[9])
#define w_gate_up (ka->in[10])
#define w_down (ka->in[11])
#define g_kv (ka->in[12])
#define w_kv_shared (ka->in[13])
#define lambda_qk (ka->in[14])
#define g_subln (ka->in[15])
#define g_final (ka->in[16])
#define WINA ((bf16_t*)(ws + WS_WINA))
#define WINB ((bf16_t*)(ws + WS_WINB))
#define WMEM ((bf16_t*)(ws + WS_WMEM))
#define WO ((bf16_t*)(ws + WS_WO))
#define WGU ((bf16_t*)(ws + WS_WGU))
#define WDN ((bf16_t*)(ws + WS_WDN))
#define WKV ((bf16_t*)(ws + WS_WKV))
#define HB ((bf16_t*)(ws + WS_H))
#define HB2 ((bf16_t*)(ws + WS_H2))
#define XN ((bf16_t*)(ws + WS_XN))
#define XKV ((bf16_t*)(ws + WS_XKV))
#define MN ((bf16_t*)(ws + WS_MN))
#define MKV ((bf16_t*)(ws + WS_MKV))
#define PROJ ((bf16_t*)(ws + WS_PROJ))
#define KVS ((bf16_t*)(ws + WS_KVS))
#define YB ((bf16_t*)(ws + WS_Y))
#define ACT ((bf16_t*)(ws + WS_ACT))
#define KM ((float*)(ws + WS_KM))
#define SSB ((float*)(ws + WS_SS))
#define RSL ((LAS float*)(ldsL + 131072))
  LAS unsigned char* ldsL = (LAS unsigned char*)lds;
  { volatile LAS unsigned* st0 = (volatile LAS unsigned*)(ldsL + LDS_BYTES - 16); if (threadIdx.x < 2) st0[threadIdx.x] = 0u; }
  __syncthreads();
#if MK_N_LAUNCHES == 1
  XcdBarrier xbar; xbar.bar = (unsigned*)(a.ws + WS_CTL) + 4096; xbar.x = 0; xbar.st = (volatile LAS unsigned*)(ldsL + LDS_BYTES - 16);
  if (blockIdx.x == 0) for (int i = threadIdx.x; i < XCD_BAR_WORDS; i += 512) __hip_atomic_store(xbar.bar + i, 0u, __ATOMIC_RELAXED, __HIP_MEMORY_SCOPE_AGENT);
#else
  XcdBarrier xbar = xcd_barrier_post((unsigned*)(a.ws + WS_CTL) + 4096, (volatile LAS unsigned*)(ldsL + LDS_BYTES - 16));
#endif

  for (int rep = 0; rep < REPS(0); ++rep) {
  if (RUN(0)) { PHASE_BEGIN
    if (bid == 0 && tid < 8) __hip_atomic_store(ctl + tid, 0u, __ATOMIC_RELAXED, __HIP_MEMORY_SCOPE_AGENT);
    if (bid == 0 && tid >= 64 && tid < 66) { const int j = tid - 64; const float* lq = lambda_qk + j * 256; float s1 = 0.f, s2 = 0.f;
      for (int i = 0; i < 64; ++i) { s1 += lq[i] * lq[64 + i]; s2 += lq[128 + i] * lq[192 + i]; }
      const float lam_init = 0.8f - 0.6f * expf(-0.3f * (float)(2 + j)); ((float*)ctl)[16 + j] = expf(s1) - expf(s2) + lam_init; ((float*)ctl)[18 + j] = 1.0f - lam_init; }
    LAS float* scr = (LAS float*)(ldsL + wave * 16640);
    constexpr int I_INA = (DM / 64) * (NINA / 64), I_INB = (DM / 64) * (NINB / 64), I_MEM = (DM / 64) * (NMKV / 64), I_O = (DM / 64) * (DM / 64), I_GU = (DM / 64) * (NGU / 64), I_DN = (DFF / 64) * (DM / 64), I_KV = (DM / 64) * (NKV / 64);
    constexpr int NITEMS = 2 * I_INA + 2 * I_INB + 4 * I_MEM + 4 * I_O + 4 * I_GU + 4 * I_DN + I_KV;
    for (int it = gw; it < NITEMS; it += NGW) {
      int r = it;
      if (r < 4 * I_GU) { const int l = r / I_GU; transpose_item(w_gate_up + (size_t)l * DM * NGU, DM, NGU, WGU + (size_t)l * NGU * DM, true, scr, r % I_GU, lane, g_ffn + l * DM); continue; } r -= 4 * I_GU;
      if (r < 4 * I_DN) { const int l = r / I_DN; transpose_item(w_down + (size_t)l * DFF * DM, DFF, DM, WDN + (size_t)l * DM * DFF, false, scr, r % I_DN, lane); continue; } r -= 4 * I_DN;
      if (r < 2 * I_INA) { const int l = r / I_INA; transpose_item(w_in_a + (size_t)l * DM * NINA, DM, NINA, WINA + (size_t)l * NINA * DM, false, scr, r % I_INA, lane, g_mix + l * DM); continue; } r -= 2 * I_INA;
      if (r < 2 * I_INB) { const int l = r / I_INB; transpose_item(w_in_b + (size_t)l * DM * NINB, DM, NINB, WINB + (size_t)l * NINB * DM, false, scr, r % I_INB, lane, g_mix + (2 + l) * DM); continue; } r -= 2 * I_INB;
      if (r < 4 * I_MEM) { const int l = r / I_MEM; transpose_item(w_mem_kv + (size_t)l * DM * NMKV, DM, NMKV, WMEM + (size_t)l * NMKV * DM, false, scr, r % I_MEM, lane, g_mem + l * DM); continue; } r -= 4 * I_MEM;
      if (r < 4 * I_O) { const int l = r / I_O; transpose_item(w_o + (size_t)l * DM * DM, DM, DM, WO + (size_t)l * DM * DM, false, scr, r % I_O, lane); continue; } r -= 4 * I_O;
      transpose_item(w_kv_shared, DM, NKV, WKV, false, scr, r, lane, g_kv);
    }
    for (int m = gw; m < NTOK; m += 4 * NGW) rms_rows<4>(X_IN, m, NGW, NTOK, lane, nullptr, XN, nullptr);
    for (int m = gw; m < NMTOK; m += 2 * NGW) rms_rows<2>(MEM_IN, m, NGW, NMTOK, lane, nullptr, MN, nullptr);
    __syncthreads();
  }
  if (RUN(0) && RUN(1)) { if (rep == 0) { grid.sync();
#if MK_N_LAUNCHES == 1
      xbar = xcd_barrier_post((unsigned*)(a.ws + WS_CTL) + 4096, (volatile LAS unsigned*)(ldsL + LDS_BYTES - 16));
#endif
    } else GSYNC(); }
  }

#pragma unroll 1
  for (int l = 0; l < DEPTH; ++l) {
    const int pb = 1 + 8 * l; const bool moba = l < 2; const int j = l - 2;
    const int ldp = moba ? NINA : NINB;
    for (int rep = 0; rep < REPS(1); ++rep) {
    if (RUN(pb)) { PHASE_BEGIN
      const int ng = 1 + (l == 0 ? 4 : 0) + (l == 2 ? 1 : 0);
#pragma unroll 1
      for (int gi = 0; gi < ng; ++gi) {
        pg8::Gemm g; pg8::EpiBf16S E{nullptr, 0, nullptr, nullptr}; int coff = 0; const float* ssp = nullptr;
        if (gi == 0) { g = pg8::Gemm{l == 0 ? XN : HB, moba ? WINA + (size_t)l * NINA * DM : WINB + (size_t)j * NINB * DM, NTOK, ldp, DM}; E.O = PROJ; E.ldc = ldp; if (l > 0) ssp = SSB; if (moba) E.kmp = KM; }
        else if (l == 0) { const int ml = gi - 1; g = pg8::Gemm{MN, WMEM + (size_t)ml * NMKV * DM, NMTOK, NMKV, DM}; E.O = MKV + (size_t)ml * NMTOK * NMKV; E.ldc = NMKV; coff = 128 + 16 * ml; }
        else { g = pg8::Gemm{HB, WKV, NTOK, NKV, DM}; E.O = KVS; E.ldc = NKV; ssp = SSB; }
        if (ssp) E.rs = RSL;
        pg8::RsOrder S; S.so.init(g.M, g.N, G, (bid + G - (coff % G)) % G); S.ss = ssp; S.rs = RSL; S.so.allow_half = (l > 0) ? 1 : 0; S.build();
        pg8::gemm_phase<pg8::EpiBf16S, pg8::RsOrder, true, true>(ldsL, g, S, E);
      }
    }
    SEAM(pb);
    }
    for (int rep = 0; rep < REPS(3); ++rep) {
    if (RUN(pb + 2)) { PHASE_BEGIN
      volatile unsigned* misc = (volatile unsigned*)(lds + att::OFF_MISC);
      const int nself = moba ? NB * NSH * 8 : NB * NSH * 16, NU = nself + NB * NMH * 8;
      if (tid == 0) misc[0] = atomicAdd(ctl + l + 4 * rep, 1u);
      __syncthreads();
      for (;;) {
        const int u = (int)misc[0];
        if (u >= NU) break;
        att::UnitP P; P.bias_col = rel_bias; P.km = nullptr; P.lamp = nullptr; P.gsub = nullptr; P.qb = 0; P.ldy = DM; P.ticket = ctl + l + 4 * rep;
        if (u < nself) {
          const int idx = u % 48, b = idx / NSH, h = idx % NSH; P.bias_col = rel_bias + h;
          if (moba) { const int qb = 7 - u / 48;
            P.Q = PROJ + (size_t)(b * SEQ + qb * 256) * NINA + h * HD; P.ldq = NINA; P.K = PROJ + (size_t)(b * SEQ) * NINA + SW + h * HD; P.V = P.K + SW; P.ldk = NINA;
            P.Y = YB + (size_t)(b * SEQ + qb * 256) * DM + h * HD; P.NT = 4 * (qb + 1); P.qpos0 = qb * 256; P.qb = qb; P.km = KM + (size_t)(b * 8) * 4 * 1536 + h * HD;
            att::attn_unit<1>(ldsL, P);
          } else { const int qt = 15 - u / 48;
            P.Q = PROJ + (size_t)(b * SEQ + qt * 128) * NINB + h * HD; P.ldq = NINB; P.K = KVS + (size_t)(b * SEQ) * NKV + h * HD; P.V = P.K + SW; P.ldk = NKV;
            P.Y = YB + (size_t)(b * SEQ + qt * 128) * DM + h * HD; P.NT = 2 * (qt + 1); P.qpos0 = qt * 128;
            P.lamp = (const float*)ctl + 16 + j; P.gsub = g_subln + j * HD;
            att::attn_unit<2>(ldsL, P);
          }
        } else {
          const int m = u - nself, b = m >> 5, hm = (m >> 3) & 3, qb = m & 7;
          P.Q = PROJ + (size_t)(b * SEQ + qb * 256) * ldp + (ldp - MW) + hm * HD; P.ldq = ldp;
          P.K = MKV + (size_t)l * NMTOK * NMKV + (size_t)(b * NMEM) * NMKV + hm * HD; P.V = P.K + MW; P.ldk = NMKV;
          P.Y = YB + (size_t)(b * SEQ + qb * 256) * DM + SW + hm * HD; P.NT = 4; P.qpos0 = 0;
          att::attn_unit<0>(ldsL, P);
        }
      }
    }
    SEAM(pb + 2);
    }
    for (int rep = 0; rep < REPS(4); ++rep) {
    if (RUN(pb + 3)) { PHASE_BEGIN
      pg8::Gemm g{YB, WO + (size_t)l * DM * DM, NTOK, DM, DM}; pg8::EpiResid E{l == 0 ? X_IN : nullptr, HB, HB2, DM, SSB};
      pg8::StaticOrder S; S.init(NTOK, DM, G, bid);
      pg8::gemm_phase<pg8::EpiResid, pg8::StaticOrder, true, true>(ldsL, g, S, E);
    }
    SEAM(pb + 3);
    }
    for (int rep = 0; rep < REPS(6); ++rep) {
    if (RUN(pb + 5)) { PHASE_BEGIN
      pg8::Gemm g{HB2, WGU + (size_t)l * NGU * DM, NTOK, NGU, DM}; pg8::EpiSwiGLU E{ACT, DFF, RSL};
      pg8::RsOrder S; S.so.init(NTOK, NGU, G, bid); S.ss = SSB; S.rs = RSL; S.so.allow_half = 1; S.build();
      pg8::gemm_phase<pg8::EpiSwiGLU, pg8::RsOrder, true, true>(ldsL, g, S, E);
    }
    SEAM(pb + 5);
    }
    for (int rep = 0; rep < REPS(7); ++rep) {
    if (RUN(pb + 6)) { PHASE_BEGIN
      pg8::Gemm g{ACT, WDN + (size_t)l * DM * DFF, NTOK, DM, DFF}; pg8::EpiResid E{nullptr, HB2, HB, DM, l < DEPTH - 1 ? SSB : nullptr};
      pg8::StaticOrder S; S.init(NTOK, DM, G, bid);
      pg8::gemm_phase<pg8::EpiResid, pg8::StaticOrder, true, true>(ldsL, g, S, E);
    }
    if (RUN(pb + 6) && (l == DEPTH - 1 ? RUN(pb + 7) : RUN(pb + 8))) GSYNC();
    }
    for (int rep = 0; rep < REPS(8); ++rep) {
    if (RUN(pb + 7) && l == DEPTH - 1) { PHASE_BEGIN
      for (int m = gw; m < NTOK; m += 4 * NGW) rms_rows_h<4>(HB, m, NGW, NTOK, lane, g_final, ka->out);
    }
    }
  }
#undef RUN
#undef SEAM
}

extern "C" void kernel_launch(void* const* d_in, const int* in_sizes, int n_in, void* d_out, int out_size, void* d_ws, size_t ws_size, hipStream_t stream) {
  static int grid = 0;
  if (grid == 0) {
    if (n_in != 17 || in_sizes[0] != NTOK * DM || out_size != NTOK * DM || ws_size < WS_END) { fprintf(stderr, "kernel_launch: unexpected shapes (n_in %d, in0 %d, out %d, ws %zu)\n", n_in, n_in > 0 ? in_sizes[0] : -1, out_size, ws_size); grid = -1; return; }
    int dev = 0, cus = 0, per_cu = 0;
    if (hipGetDevice(&dev) != hipSuccess || hipDeviceGetAttribute(&cus, hipDeviceAttributeMultiprocessorCount, dev) != hipSuccess) { grid = -1; return; }
    if (hipFuncSetAttribute((const void*)fwd, hipFuncAttributeMaxDynamicSharedMemorySize, LDS_BYTES) != hipSuccess) { fprintf(stderr, "kernel_launch: hipFuncSetAttribute failed\n"); grid = -1; return; }
    if (hipOccupancyMaxActiveBlocksPerMultiprocessor(&per_cu, (const void*)fwd, 512, LDS_BYTES) != hipSuccess || per_cu < 1) { fprintf(stderr, "kernel_launch: occupancy query says %d\n", per_cu); per_cu = 1; }
    (void)hipGetLastError();
    grid = cus * 1;
  }
  if (grid < 0) return;
#if MK_N_LAUNCHES != 1
  if (hipMemsetAsync((char*)d_ws + WS_CTL, 0, 65536, stream) != hipSuccess) { fprintf(stderr, "kernel_launch: memset failed\n"); return; }
#endif
  Args a{};
  for (int i = 0; i < 17; ++i) a.in[i] = (const float*)d_in[i];
  a.out = (float*)d_out; a.ws = (unsigned char*)d_ws;
#if MK_N_LAUNCHES == 1
  a.ph_lo = 0; a.ph_hi = N_PHASES;
  void* args[] = {&a};
  hipError_t e = hipLaunchCooperativeKernel((const void*)fwd, dim3(grid), dim3(512), args, LDS_BYTES, stream);
  if (e != hipSuccess) fprintf(stderr, "cooperative launch failed: %s (grid %d)\n", hipGetErrorString(e), grid);
#else
  for (int p = 0; p < N_PHASES; ++p) {
    if (p >= 1) { const int l = (p - 1) / 8, k = (p - 1) % 8; if (k == 1 || k == 4 || (k == 7 && l < 3)) continue; }
    a.ph_lo = p; a.ph_hi = p + 1;
    hipLaunchKernelGGL(fwd, dim3(grid), dim3(512), LDS_BYTES, stream, a);
  }
#endif
}
```
